# Optimizing an MI355X kernel written in HIP

```python
import math
import jax, jax.numpy as jnp
from jax import lax
import numpy as np

D_MODEL = 2048
BATCH = 16
SEQ = 2048
DEPTH = 4

CHUNK = 64
N_A_LAYERS = DEPTH // 2
N_B_LAYERS = DEPTH - N_A_LAYERS
SSM_WIDTH = D_MODEL
SSM_GROUP = 16
SSM_GROUPS = SSM_WIDTH // SSM_GROUP
SSM_STATE = 64
HEAD_DIM = 128
N_HEADS = D_MODEL // HEAD_DIM
N_KV_HEADS = 4
Q_PER_KV = N_HEADS // N_KV_HEADS
Q_BLOCK = 128
D_FF = 4 * D_MODEL
PLE_DIM = 256
NORM_EPS = 1e-6
DT_MIN = 1e-3
DT_MAX = 1e-1

kernel_name = "yoco_s5_stickbreaking_hybrid"


def rms_norm(x, g):
    x32 = x.astype(jnp.float32)
    y = x32 * lax.rsqrt(jnp.mean(x32 * x32, axis=-1, keepdims=True) + NORM_EPS)
    return (y * g.astype(jnp.float32)).astype(x.dtype)


def _complex_affine_combine(e1, e2):
    a1r, a1i, b1r, b1i = e1
    a2r, a2i, b2r, b2i = e2
    ar = a2r * a1r - a2i * a1i
    ai = a2r * a1i + a2i * a1r
    br = a2r * b1r - a2i * b1i + b2r
    bi = a2r * b1i + a2i * b1r + b2i
    return (ar, ai, br, bi)


def s5_mixer(h, w_in, a_re, a_im, log_step, b_re, b_im, c_re, c_im, d_skip, w_glu):
    f32 = jnp.float32
    bsz, seq, _ = h.shape
    u = (h @ w_in).astype(f32).reshape(bsz, seq, SSM_GROUPS, SSM_GROUP)
    dt = jnp.exp(log_step.astype(f32))[:, None]
    ar = a_re.astype(f32)
    ai = a_im.astype(f32)
    mag = jnp.exp(ar * dt)
    lbr = mag * jnp.cos(ai * dt)
    lbi = mag * jnp.sin(ai * dt)
    den = ar * ar + ai * ai
    nr = lbr - 1.0
    fr = (nr * ar + lbi * ai) / den
    fi = (lbi * ar - nr * ai) / den
    br = b_re.astype(f32)
    bi = b_im.astype(f32)
    bbr = fr[..., None] * br - fi[..., None] * bi
    bbi = fr[..., None] * bi + fi[..., None] * br
    bu_re = jnp.einsum('bsgh,gph->bsgp', u, bbr)
    bu_im = jnp.einsum('bsgh,gph->bsgp', u, bbi)
    lam_re = jnp.broadcast_to(lbr[None, None], bu_re.shape)
    lam_im = jnp.broadcast_to(lbi[None, None], bu_im.shape)
    _, _, xs_re, xs_im = lax.associative_scan(
        _complex_affine_combine, (lam_re, lam_im, bu_re, bu_im), axis=1)
    y = (jnp.einsum('bsgp,ghp->bsgh', xs_re, c_re.astype(f32))
         - jnp.einsum('bsgp,ghp->bsgh', xs_im, c_im.astype(f32))
         + d_skip.astype(f32).reshape(SSM_GROUPS, SSM_GROUP) * u)
    y = jax.nn.gelu(y.reshape(bsz, seq, SSM_WIDTH)).astype(h.dtype)
    val, gate = jnp.split(y @ w_glu, 2, axis=-1)
    return val * jax.nn.sigmoid(gate)


def stick_breaking_attention(q, k, v):
    seq = q.shape[1]
    scale = HEAD_DIM ** -0.5
    outs = []
    for blk in range(seq // Q_BLOCK):
        q0 = blk * Q_BLOCK
        end = q0 + Q_BLOCK
        qb = q[:, q0:end]
        kb = k[:, :end]
        vb = v[:, :end]
        z = jnp.einsum('bqhgd,bkhd->bhgqk', qb, kb,
                       preferred_element_type=jnp.float32) * scale
        t_pos = q0 + jnp.arange(Q_BLOCK)[:, None]
        s_pos = jnp.arange(end)[None, :]
        strict = s_pos < t_pos
        log_keep = jnp.where(strict, jax.nn.log_sigmoid(-z), 0.0)
        after = lax.cumsum(log_keep, axis=log_keep.ndim - 1, reverse=True) - log_keep
        w = jnp.where(strict, jnp.exp(jax.nn.log_sigmoid(z) + after), 0.0)
        outs.append(jnp.einsum('bhgqk,bkhd->bqhgd', w.astype(vb.dtype), vb))
    return jnp.concatenate(outs, axis=1)


def setup_inputs(seed: int = 0) -> dict:
    key = jax.random.key(seed)
    ks = jax.random.split(key, 32)
    f32 = jnp.float32
    D, H, G, P, Hg = D_MODEL, SSM_WIDTH, SSM_GROUPS, SSM_STATE, SSM_GROUP
    nA, nB = N_A_LAYERS, N_B_LAYERS
    kvw = N_KV_HEADS * HEAD_DIM
    qw = N_HEADS * HEAD_DIM

    def nrm(k, shape, scale):
        return jax.random.normal(k, shape, f32) * scale

    def gain(k, shape):
        return 1.0 + 0.01 * jax.random.normal(k, shape, f32)

    n_idx = jnp.arange(P, dtype=f32)
    return {
        "x": nrm(ks[0], (BATCH, SEQ, D), 1.0),
        "p": nrm(ks[1], (DEPTH, BATCH, SEQ, PLE_DIM), 1.0),
        "a_norm_pre": gain(ks[2], (nA, D)),
        "a_norm_post": gain(ks[3], (nA, D)),
        "ssm_w_in": nrm(ks[4], (nA, D, H), D ** -0.5),
        "ssm_a_re": -0.5 + 0.01 * jax.random.normal(ks[5], (nA, G, P), f32),
        "ssm_a_im": math.pi * n_idx + 0.01 * jax.random.normal(ks[6], (nA, G, P), f32),
        "ssm_log_step": jax.random.uniform(ks[7], (nA, G), f32,
                                           minval=math.log(DT_MIN), maxval=math.log(DT_MAX)),
        "ssm_b_re": nrm(ks[8], (nA, G, P, Hg), (2 * Hg) ** -0.5),
        "ssm_b_im": nrm(ks[9], (nA, G, P, Hg), (2 * Hg) ** -0.5),
        "ssm_c_re": nrm(ks[10], (nA, G, Hg, P), (2 * P) ** -0.5),
        "ssm_c_im": nrm(ks[11], (nA, G, Hg, P), (2 * P) ** -0.5),
        "ssm_d": nrm(ks[12], (nA, H), 0.5),
        "ssm_w_glu": nrm(ks[13], (nA, H, 2 * D), H ** -0.5),
        "kv_norm": gain(ks[14], (D,)),
        "w_k": nrm(ks[15], (D, kvw), D ** -0.5),
        "w_v": nrm(ks[16], (D, kvw), D ** -0.5),
        "b_norm_pre": gain(ks[17], (nB, D)),
        "b_norm_post": gain(ks[18], (nB, D)),
        "w_q": nrm(ks[19], (nB, D, qw), D ** -0.5),
        "w_o": nrm(ks[20], (nB, qw, D), qw ** -0.5),
        "mlp_norm_pre": gain(ks[21], (DEPTH, D)),
        "mlp_norm_post": gain(ks[22], (DEPTH, D)),
        "mlp_w1": nrm(ks[23], (DEPTH, D, D_FF), D ** -0.5),
        "mlp_w2": nrm(ks[24], (DEPTH, D_FF, D), D_FF ** -0.5),
        "ple_w": nrm(ks[25], (DEPTH, PLE_DIM, D), PLE_DIM ** -0.5),
        "ple_gate": nrm(ks[26], (DEPTH, D, D), D ** -0.5),
    }


def reference(x, p, a_norm_pre, a_norm_post, ssm_w_in, ssm_a_re, ssm_a_im, ssm_log_step,
              ssm_b_re, ssm_b_im, ssm_c_re, ssm_c_im, ssm_d, ssm_w_glu,
              kv_norm, w_k, w_v, b_norm_pre, b_norm_post, w_q, w_o,
              mlp_norm_pre, mlp_norm_post, mlp_w1, mlp_w2, ple_w, ple_gate):
    bsz, seq, _ = x.shape
    h = x
    k_sh = None
    v_sh = None
    for i in range(DEPTH):
        if i < N_A_LAYERS:
            j = i
            m = s5_mixer(rms_norm(h, a_norm_pre[j]), ssm_w_in[j], ssm_a_re[j], ssm_a_im[j],
                         ssm_log_step[j], ssm_b_re[j], ssm_b_im[j], ssm_c_re[j], ssm_c_im[j],
                         ssm_d[j], ssm_w_glu[j])
            h = h + rms_norm(m, a_norm_post[j])
        else:
            j = i - N_A_LAYERS
            if j == 0:
                kv_in = rms_norm(h, kv_norm)
                k_sh = (kv_in @ w_k).reshape(bsz, seq, N_KV_HEADS, HEAD_DIM)
                v_sh = (kv_in @ w_v).reshape(bsz, seq, N_KV_HEADS, HEAD_DIM)
            q = (rms_norm(h, b_norm_pre[j]) @ w_q[j]).reshape(
                bsz, seq, N_KV_HEADS, Q_PER_KV, HEAD_DIM)
            o = stick_breaking_attention(q, k_sh, v_sh).reshape(bsz, seq, N_HEADS * HEAD_DIM)
            h = h + rms_norm(o @ w_o[j], b_norm_post[j])
        f = rms_norm(h, mlp_norm_pre[i]) @ mlp_w1[i]
        f = jnp.square(jax.nn.relu(f)) @ mlp_w2[i]
        h = h + rms_norm(f, mlp_norm_post[i])
        h = h + (p[i] @ ple_w[i]) * jax.nn.sigmoid(h @ ple_gate[i])
    return h
```

```cpp
#include <hip/hip_runtime.h>
#include <cstdio>
#include <cstdint>
#include <cstdlib>
#include <vector>

#define XB_TMO      128
#define XB_XCNT(j)  (256  + 64 * (j))
#define XB_XSUB(j)  (1280 + 64 * (j))
#define XB_XGEN(j)  (2304 + 64 * (j))
#define XB_TOP      3328
#define XB_TOPGEN   3392
#define XCD_BAR_WORDS 3456
#define XB_SPIN_CAP (1u << 18)
#define LAS __attribute__((address_space(3)))

__device__ __forceinline__ unsigned xb_ld(unsigned* p)              { return __hip_atomic_load(p, __ATOMIC_RELAXED, __HIP_MEMORY_SCOPE_AGENT); }
__device__ __forceinline__ unsigned xb_add(unsigned* p, unsigned v) { return __hip_atomic_fetch_add(p, v, __ATOMIC_RELAXED, __HIP_MEMORY_SCOPE_AGENT); }
__device__ __forceinline__ unsigned xb_xcc_id() { return (unsigned)__builtin_amdgcn_s_getreg((3 << 11) | 20) & 0xFu; }
#define XB_SPIN(cond, bar) do { unsigned _sp = 0; while (cond) { __builtin_amdgcn_s_sleep(1); \
    if ((++_sp & 255u) == 0u) { if (xb_ld(&(bar)[XB_TMO])) break; if (_sp > XB_SPIN_CAP) { atomicAdd(&(bar)[XB_TMO], 1u); break; } } } } while (0)

struct XcdBarrier {
    unsigned* bar; unsigned x;
    volatile LAS unsigned* st;
};

__device__ __forceinline__ XcdBarrier xcd_barrier_post(unsigned* bar, volatile LAS unsigned* st) {
    XcdBarrier b; b.bar = bar; b.x = xb_xcc_id(); b.st = st;
    if (threadIdx.x == 0) (void)xb_add(&bar[XB_XCNT(b.x)], 1u);
    return b;
}
__device__ __forceinline__ void xcd_barrier_complete(unsigned* bar, unsigned x, unsigned& nloc, unsigned& nx) {
    const unsigned G = gridDim.x * gridDim.y * gridDim.z;
    unsigned sum, cnt, mine, sp = 0u;
    for (;;) {
        sum = 0u; cnt = 0u; mine = 0u;
#pragma unroll
        for (unsigned j = 0; j < 16; ++j) { const unsigned c = xb_ld(&bar[XB_XCNT(j)]); sum += c; cnt += (c > 0u) ? 1u : 0u; mine = (j == x) ? c : mine; }
        if (sum == G) break;
        __builtin_amdgcn_s_sleep(1);
        if ((++sp & 255u) == 0u) { if (xb_ld(&bar[XB_TMO])) break; if (sp > XB_SPIN_CAP) { atomicAdd(&bar[XB_TMO], 1u); break; } }
    }
    nloc = mine > 0u ? mine : 1u; nx = cnt > 0u ? cnt : 1u;
}

__device__ __forceinline__ void xcd_barrier(const XcdBarrier& b) {
    asm volatile("s_waitcnt vmcnt(0)" ::: "memory");
    __syncthreads();
    if (threadIdx.x == 0) {
        unsigned* bar = b.bar;
        __builtin_amdgcn_s_waitcnt(0);
        unsigned nloc = b.st[0], nx = b.st[1];
        if (nloc == 0u) { xcd_barrier_complete(bar, b.x, nloc, nx); b.st[0] = nloc; b.st[1] = nx; }
        const unsigned old = xb_add(&bar[XB_XSUB(b.x)], 1u);
        const unsigned gen = old / nloc;
        if (old + 1u == (gen + 1u) * nloc) {
            __builtin_amdgcn_fence(__ATOMIC_RELEASE, "agent");
            asm volatile("s_waitcnt vmcnt(0)" ::: "memory");
            const unsigned og = xb_add(&bar[XB_TOP], 1u);
            const unsigned tg = og / nx;
            if (og + 1u == (tg + 1u) * nx) xb_add(&bar[XB_TOPGEN], 1u);
            else XB_SPIN(xb_ld(&bar[XB_TOPGEN]) == tg, bar);
            __builtin_amdgcn_fence(__ATOMIC_ACQUIRE, "agent");
            xb_add(&bar[XB_XGEN(b.x)], 1u);
            asm volatile("s_waitcnt vmcnt(0)" ::: "memory");
        } else {
            XB_SPIN(xb_ld(&bar[XB_XGEN(b.x)]) == gen, bar);
            __builtin_amdgcn_fence(__ATOMIC_ACQUIRE, "agent");
            asm volatile("s_waitcnt vmcnt(0)" ::: "memory");
        }
    }
    __syncthreads();
}
namespace pg8 {
#define PG8_LAS __attribute__((address_space(3)))
typedef unsigned short bf16_t;
typedef short bf16x8 __attribute__((ext_vector_type(8)));
typedef float f32x4 __attribute__((ext_vector_type(4)));
typedef unsigned u32x4 __attribute__((ext_vector_type(4)));
constexpr int BM = 256, BK = 64, HALF = 128, HTB = HALF * BK * 2  , STAGE_BYTES = 8 * HTB, NXCD = 8, WGM = 8;

__host__ __device__ __forceinline__ int lds_byte(int r, int c) { const int st = (r >> 4) * 2 + (c >> 5), rr = r & 15, cc = c & 31, ob = rr * 64 + cc * 2; return st * 1024 + (ob ^ (((ob >> 9) & 1) << 5)); }
__host__ __device__ __forceinline__ void stage_rc(int b, int& R, int& C) { const int st = b / 1024, sb = b % 1024, swz = sb ^ (((sb >> 9) & 1) << 5); R = (st >> 1) * 16 + swz / 64; C = (st & 1) * 32 + (swz % 64) / 2; }
__host__ __device__ __forceinline__ int perm32(int rho) { const int n = rho >> 4, i = rho & 15; return 8 * (i >> 2) + 4 * n + (i & 3); }

struct Unit { int pm, pn; };
struct Gemm { const bf16_t* A; const bf16_t* Bt; int M, N, K; };
struct StaticOrder {
    int nM, nN, nwg, G, c;
    __host__ __device__ void init(int M, int N, int G_, int c_) { nM = M / BM; nN = N / BM; nwg = nM * nN; G = G_; c = c_; }
    __host__ __device__ bool next(int i, Unit& u) const {
        const int L = i * G + c; if (L >= nwg) return false;
        int wgid = (int)L; { const int q = nwg / NXCD, r = nwg % NXCD, xcd = wgid % NXCD, off = wgid / NXCD; wgid = (xcd < r ? xcd * (q + 1) : r * (q + 1) + (xcd - r) * q) + off; }
        const int nig = WGM * nN, gid = wgid / nig, fm = gid * WGM, gsz = (nM - fm) < WGM ? (nM - fm) : WGM;
        u.pm = fm + ((wgid % nig) % gsz); u.pn = (wgid % nig) / gsz; return true;
    }
    __device__ __forceinline__ void a_ready(const Unit&) const {}
    __device__ __forceinline__ void done(const Unit&) const {}
};
__device__ __forceinline__ unsigned cvt_pk_bf16(float lo, float hi) { unsigned r; asm volatile("v_cvt_pk_bf16_f32 %0, %1, %2" : "=v"(r) : "v"(lo), "v"(hi)); return r; }
template <class Epi, class Sched, bool STAMP = false>
__device__ __forceinline__ void gemm_phase(PG8_LAS unsigned char* lds, const Gemm g, const Sched& S, const Epi& E, unsigned long long* stamps) {
    int tid_l = threadIdx.x; asm volatile("" : "+v"(tid_l));
    const int tid = tid_l, wid = __builtin_amdgcn_readfirstlane(tid >> 6), lane = tid & 63, wr = wid >> 2, wc = wid & 3, fr = lane & 15, fq = lane >> 4;
    const int K = g.K, nt = K / BK;
    int ts_lo = 0, ts_hi = 0, nts = 0; const unsigned long long rt_entry = STAMP ? (unsigned long long)wall_clock64() : 0ull;
#define PG8_STAMP() do { if (STAMP && wid == 0 && nts < 64) { const unsigned long long _c = (unsigned long long)clock64(); \
        ts_lo = (lane == nts) ? (int)(unsigned)_c : ts_lo; ts_hi = (lane == nts) ? (int)(unsigned)(_c >> 32) : ts_hi; ++nts; } } while (0)
    PG8_STAMP();
    unsigned voffA[2], voffB[2];
#pragma unroll
    for (int i = 0; i < 2; ++i) { int R, C; stage_rc(tid * 16 + i * 8192, R, C); const int Rb = Epi::PERM ? ((R & ~31) + perm32(R & 31)) : R;
        voffA[i] = (unsigned)(R * K + C) * 2u; voffB[i] = (unsigned)(Rb * K + C) * 2u; }
    const size_t kstep = (size_t)(BK * 2);
    const size_t hstep = (size_t)HALF * K * 2;
    const size_t tstep = 2 * hstep;
    const unsigned ldsw = (unsigned)wid * 1024u;
    const int aoff = lds_byte(wr * 64 + fr, fq * 8), boff = lds_byte(wc * 32 + fr, fq * 8);
#define PG8_SA(b, h) (((b) * 2 + (h)) * HTB)
#define PG8_SB(b, h) ((4 + (b) * 2 + (h)) * HTB)
#define PG8_STAGE(bufoff, gbase, voff) do { _Pragma("unroll") for (int _i = 0; _i < 2; ++_i) \
        __builtin_amdgcn_global_load_lds((const unsigned*)((const char*)(gbase) + (voff)[_i]), (PG8_LAS unsigned*)(lds + (bufoff) + ldsw + _i * 8192), 16, 0, 0); } while (0)
#define PG8_LDA(dst, b, h) do { _Pragma("unroll") for (int m = 0; m < 4; ++m) _Pragma("unroll") for (int k = 0; k < 2; ++k) dst[m][k] = *(const PG8_LAS bf16x8*)(lds + PG8_SA(b, h) + aoff + m * 2048 + k * 1024); } while (0)
#define PG8_LDB(dst, b, h) do { _Pragma("unroll") for (int n = 0; n < 2; ++n) _Pragma("unroll") for (int k = 0; k < 2; ++k) dst[n][k] = *(const PG8_LAS bf16x8*)(lds + PG8_SB(b, h) + boff + n * 2048 + k * 1024); } while (0)
#define PG8_MMA(ai, bj, At, Bt) do { __builtin_amdgcn_s_setprio(1); _Pragma("unroll") for (int m = 0; m < 4; ++m) _Pragma("unroll") for (int n = 0; n < 2; ++n) _Pragma("unroll") for (int k = 0; k < 2; ++k) \
        acc[ai][bj][m][n] = __builtin_amdgcn_mfma_f32_16x16x32_bf16(Bt[n][k], At[m][k], acc[ai][bj][m][n], 0, 0, 0); __builtin_amdgcn_s_setprio(0); } while (0)
#define PG8_WAIT_V(n) asm volatile("s_waitcnt vmcnt(" #n ")" ::: "memory")
#define PG8_WAIT_L(n) asm volatile("s_waitcnt lgkmcnt(" #n ")" ::: "memory")
#define PG8_BAR __builtin_amdgcn_s_barrier()
#define PG8_SCHED __builtin_amdgcn_sched_barrier(0)
    Unit cur, nxt; int ui = 0;
    if (!S.next(0, cur)) return;
    f32x4 acc[2][2][4][2];
#pragma unroll
    for (int a = 0; a < 2; ++a)
#pragma unroll
        for (int b = 0; b < 2; ++b)
#pragma unroll
            for (int m = 0; m < 4; ++m)
#pragma unroll
                for (int n = 0; n < 2; ++n) acc[a][b][m][n] = (f32x4){0.f, 0.f, 0.f, 0.f};
    bf16x8 At[4][2], B0[2][2], B1[2][2];
    const char* cA = (const char*)g.A + (size_t)cur.pm * tstep; const char* cB = (const char*)g.Bt + (size_t)cur.pn * tstep;
    S.a_ready(cur);
    PG8_STAGE(PG8_SB(0, 0), cB, voffB); PG8_STAGE(PG8_SA(0, 0), cA, voffA); PG8_STAGE(PG8_SB(0, 1), cB + hstep, voffB); PG8_STAGE(PG8_SA(0, 1), cA + hstep, voffA);
    if (wr == 1) PG8_BAR;
    PG8_WAIT_V(4); PG8_BAR;
    PG8_STAGE(PG8_SB(1, 0), cB + kstep, voffB); PG8_STAGE(PG8_SA(1, 0), cA + kstep, voffA); PG8_STAGE(PG8_SB(1, 1), cB + hstep + kstep, voffB);
    PG8_WAIT_V(6); PG8_BAR;
    PG8_STAMP();
    for (;;) {
        const bool has_next = S.next(ui + 1, nxt);
        const char* nA = has_next ? (const char*)g.A + (size_t)nxt.pm * tstep : cA; const char* nB = has_next ? (const char*)g.Bt + (size_t)nxt.pn * tstep : cB;
        for (int t = 0; t < nt; t += 2) {
            const bool last = (t == nt - 2);
            const char* a1 = cA + (size_t)(t + 1) * kstep;
            const char* a2 = last ? nA : cA + (size_t)(t + 2) * kstep; const char* b2 = last ? nB : cB + (size_t)(t + 2) * kstep;
            const char* a3 = a2 + kstep; const char* b3 = b2 + kstep;
            if (last && has_next) S.a_ready(nxt);
            PG8_LDB(B0, 0, 0); PG8_SCHED; PG8_LDA(At, 0, 0); PG8_STAGE(PG8_SA(1, 1), a1 + hstep, voffA);
            PG8_WAIT_L(8); PG8_BAR; PG8_WAIT_L(0); PG8_MMA(0, 0, At, B0); PG8_BAR; PG8_SCHED;
            PG8_LDB(B1, 0, 1); PG8_STAGE(PG8_SB(0, 0), b2, voffB);
            PG8_BAR; PG8_WAIT_L(0); PG8_MMA(0, 1, At, B1); PG8_BAR;
            PG8_LDA(At, 0, 1); PG8_STAGE(PG8_SA(0, 0), a2, voffA);
            PG8_BAR; PG8_WAIT_L(0); PG8_MMA(1, 0, At, B0); PG8_BAR; PG8_SCHED;
            PG8_STAGE(PG8_SB(0, 1), b2 + hstep, voffB);
            PG8_WAIT_V(6); PG8_BAR; PG8_MMA(1, 1, At, B1); PG8_BAR;
            PG8_LDB(B0, 1, 0); PG8_SCHED; PG8_LDA(At, 1, 0); PG8_STAGE(PG8_SA(0, 1), a2 + hstep, voffA);
            PG8_WAIT_L(8); PG8_BAR; PG8_WAIT_L(0); PG8_MMA(0, 0, At, B0); PG8_BAR; PG8_SCHED;
            PG8_LDB(B1, 1, 1); PG8_STAGE(PG8_SB(1, 0), b3, voffB);
            PG8_BAR; PG8_WAIT_L(0); PG8_MMA(0, 1, At, B1); PG8_BAR;
            PG8_LDA(At, 1, 1); PG8_STAGE(PG8_SA(1, 0), a3, voffA);
            PG8_BAR; PG8_WAIT_L(0); PG8_MMA(1, 0, At, B0); PG8_BAR; PG8_SCHED;
            PG8_STAGE(PG8_SB(1, 1), b3 + hstep, voffB);
            PG8_WAIT_V(6); PG8_BAR; PG8_MMA(1, 1, At, B1); PG8_BAR;
        }
        PG8_STAMP();
        if constexpr (!Epi::AFTER_DRAIN) { int l2 = threadIdx.x; asm volatile("" : "+v"(l2)); l2 &= 63; E(acc, cur, wr, wc, l2 & 15, l2 >> 4); S.done(cur); }
        PG8_STAMP();
        if (!has_next) break;
#pragma unroll
        for (int a = 0; a < 2; ++a)
#pragma unroll
            for (int b = 0; b < 2; ++b)
#pragma unroll
                for (int m = 0; m < 4; ++m)
#pragma unroll
                    for (int n = 0; n < 2; ++n) acc[a][b][m][n] = (f32x4){0.f, 0.f, 0.f, 0.f};
        cur = nxt; cA = nA; cB = nB; ++ui;
    }
    PG8_WAIT_V(0);
    if (wr == 0) PG8_BAR;
    PG8_BAR;
    if constexpr (Epi::AFTER_DRAIN) { E.fused(acc, cur, wr, wc, fr, fq, lds, wid, lane); S.done(cur); }
    PG8_STAMP();
    if (STAMP && wid == 0) { stamps[lane] = lane < nts ? (((unsigned long long)(unsigned)ts_hi << 32) | (unsigned)ts_lo) : 0ull;
        if (lane == 62) stamps[62] = rt_entry; if (lane == 63) stamps[63] = (unsigned long long)wall_clock64(); }
#undef PG8_STAMP
#undef PG8_SA
#undef PG8_SB
#undef PG8_STAGE
#undef PG8_LDA
#undef PG8_LDB
#undef PG8_MMA
#undef PG8_WAIT_V
#undef PG8_WAIT_L
#undef PG8_BAR
#undef PG8_SCHED
}
}

using namespace pg8;
#define DI __device__ __forceinline__
DI int lnd_tid() { int t = threadIdx.x; asm volatile("" : "+v"(t)); return t; }
DI int lnd_bid() { int t = blockIdx.x; asm volatile("" : "+s"(t)); return t; }
typedef float f32x16 __attribute__((ext_vector_type(16)));
typedef unsigned u32x2 __attribute__((ext_vector_type(2)));

constexpr int D_ = 2048, B_ = 16, S_ = 2048, MT = B_ * S_;
constexpr int DFF = 8192, PLE = 256, NG = 128, NP = 64;
constexpr int MCH = 8192;
constexpr int LDS_GEMM = 131072;
constexpr int LDS_TOTAL = LDS_GEMM + 16;

constexpr size_t W_IN0 = 0;
constexpr size_t W_GLU0 = W_IN0 + 2ull * 2048 * 2048;
constexpr size_t W_QKV0 = W_GLU0 + 2ull * 4096 * 2048;
constexpr size_t W_Q1 = W_QKV0 + 3072ull * 2048;
constexpr size_t W_O0 = W_Q1 + 2048ull * 2048;
constexpr size_t W_10 = W_O0 + 2ull * 2048 * 2048;
constexpr size_t W_20 = W_10 + 4ull * 8192 * 2048;
constexpr size_t W_PLE0 = W_20 + 4ull * 8192 * 2048;
constexpr size_t W_GATE0 = W_PLE0 + 4ull * 2048 * 256;
constexpr size_t W_TOTAL = W_GATE0 + 4ull * 2048 * 2048;

constexpr size_t OFF_BAR = 0;
constexpr size_t OFF_WB = 65536;
constexpr size_t OFF_XN = OFF_WB + W_TOTAL * 2;
constexpr size_t OFF_BIG = OFF_XN + (size_t)MT * D_ * 2;
constexpr size_t OFF_T32 = OFF_BIG + (size_t)MT * D_ * 2;
constexpr size_t OFF_KB = OFF_T32 + (size_t)MT * D_ * 4;
constexpr size_t OFF_VT = OFF_KB + (size_t)MT * 512 * 2;
constexpr size_t OFF_PB = OFF_VT + (size_t)MT * 512 * 2;
constexpr size_t WS_NEED = OFF_PB + (size_t)MT * PLE * 2;

struct Params {
    const float* x; const float* p; const float* a_norm_pre; const float* a_norm_post; const float* ssm_w_in; const float* ssm_a_re; const float* ssm_a_im;
    const float* ssm_log_step; const float* ssm_b_re; const float* ssm_b_im; const float* ssm_c_re; const float* ssm_c_im; const float* ssm_d; const float* ssm_w_glu;
    const float* kv_norm; const float* w_k; const float* w_v; const float* b_norm_pre; const float* b_norm_post; const float* w_q; const float* w_o;
    const float* mlp_norm_pre; const float* mlp_norm_post; const float* mlp_w1; const float* mlp_w2; const float* ple_w; const float* ple_gate;
    float* h; unsigned* bar; bf16_t* wb; bf16_t* xn; bf16_t* big; float* t32; bf16_t* kb; bf16_t* vt; bf16_t* pb;
};

DI bf16_t f2bf(float f) { unsigned u = __float_as_uint(f); u += 0x7FFFu + ((u >> 16) & 1u); return (bf16_t)(u >> 16); }
DI float bf2f(bf16_t b) { return __uint_as_float(((unsigned)b) << 16); }
DI float shx(float v, int lane, int m) { return __builtin_bit_cast(float, __builtin_amdgcn_ds_bpermute((lane ^ m) << 2, __builtin_bit_cast(int, v))); }
DI float wave_sum(float v, int lane) {
#pragma unroll
    for (int o = 32; o >= 1; o >>= 1) v += shx(v, lane, o);
    return v;
}
DI float sigmoidf_(float x) { return 1.0f / (1.0f + __expf(-x)); }

struct EpiF32s {
    static constexpr bool PERM = false, AFTER_DRAIN = false;
    float* C; int ldc;
    DI void operator()(const f32x4 (&acc)[2][2][4][2], const Unit& u, int wr, int wc, int fr, int fq) const {
        const int row0 = u.pm * BM + wr * 64 + fr, col0 = u.pn * BM + wc * 32 + 4 * fq;
#pragma unroll
        for (int ai = 0; ai < 2; ++ai)
#pragma unroll
            for (int m = 0; m < 4; ++m) { float* rowp = C + (size_t)(row0 + ai * HALF + m * 16) * ldc + col0;
#pragma unroll
                for (int bj = 0; bj < 2; ++bj)
#pragma unroll
                    for (int n = 0; n < 2; ++n) *(f32x4*)(rowp + bj * HALF + n * 16) = acc[ai][bj][m][n]; }
    }
};
struct EpiGlu {
    static constexpr bool PERM = false, AFTER_DRAIN = false;
    float* C;
    DI void operator()(const f32x4 (&acc)[2][2][4][2], const Unit& u, int wr, int wc, int fr, int fq) const {
        const int row0 = u.pm * BM + wr * 64 + fr, col0 = u.pn * HALF + wc * 32 + 4 * fq;
#pragma unroll
        for (int ai = 0; ai < 2; ++ai)
#pragma unroll
            for (int m = 0; m < 4; ++m) { float* rowp = C + (size_t)(row0 + ai * HALF + m * 16) * D_ + col0;
#pragma unroll
                for (int n = 0; n < 2; ++n) { const f32x4 v = acc[ai][0][m][n], g = acc[ai][1][m][n]; f32x4 o;
#pragma unroll
                    for (int j = 0; j < 4; ++j) o[j] = v[j] * sigmoidf_(g[j]);
                    *(f32x4*)(rowp + n * 16) = o; } }
    }
};
struct EpiPle {
    static constexpr bool PERM = false, AFTER_DRAIN = false;
    float* H; const float* G;
    DI void operator()(const f32x4 (&acc)[2][2][4][2], const Unit& u, int wr, int wc, int fr, int fq) const {
        const int row0 = u.pm * BM + wr * 64 + fr, col0 = u.pn * BM + wc * 32 + 4 * fq;
#pragma unroll
        for (int ai = 0; ai < 2; ++ai)
#pragma unroll
            for (int m = 0; m < 4; ++m) { const size_t ro = (size_t)(row0 + ai * HALF + m * 16) * D_ + col0;
#pragma unroll
                for (int bj = 0; bj < 2; ++bj)
#pragma unroll
                    for (int n = 0; n < 2; ++n) { const size_t o = ro + bj * HALF + n * 16; const f32x4 g = *(const f32x4*)(G + o); f32x4 hv = *(const f32x4*)(H + o); const f32x4 a = acc[ai][bj][m][n];
#pragma unroll
                        for (int j = 0; j < 4; ++j) hv[j] += a[j] * sigmoidf_(g[j]);
                        *(f32x4*)(H + o) = hv; } }
    }
};
template <int ACT  > struct EpiB16 {
    static constexpr bool PERM = true, AFTER_DRAIN = false;
    bf16_t* O; int ldc;
    DI void operator()(const f32x4 (&acc)[2][2][4][2], const Unit& u, int wr, int wc, int fr, int fq) const {
        const int row0 = u.pm * BM + wr * 64 + fr, col0 = u.pn * BM + wc * 32 + 8 * fq;
#pragma unroll
        for (int ai = 0; ai < 2; ++ai)
#pragma unroll
            for (int m = 0; m < 4; ++m) { bf16_t* rowp = O + (size_t)(row0 + ai * HALF + m * 16) * ldc + col0;
#pragma unroll
                for (int bj = 0; bj < 2; ++bj) { f32x4 v0 = acc[ai][bj][m][0], v1 = acc[ai][bj][m][1];
                    if (ACT == 1) {
#pragma unroll
                        for (int j = 0; j < 4; ++j) { const float a = fmaxf(v0[j], 0.f), b = fmaxf(v1[j], 0.f); v0[j] = a * a; v1[j] = b * b; } }
                    u32x4 w; w.x = cvt_pk_bf16(v0[0], v0[1]); w.y = cvt_pk_bf16(v0[2], v0[3]); w.z = cvt_pk_bf16(v1[0], v1[1]); w.w = cvt_pk_bf16(v1[2], v1[3]);
                    *(u32x4*)(rowp + bj * HALF) = w; } }
    }
};
struct EpiQKV {
    static constexpr bool PERM = true, AFTER_DRAIN = false;
    bf16_t* Qb; bf16_t* Kb; bf16_t* Vt; float qscale;
    DI void operator()(const f32x4 (&acc)[2][2][4][2], const Unit& u, int wr, int wc, int fr, int fq) const {
        const int row0 = u.pm * BM + wr * 64 + fr;
        if (u.pn < 10) {
            const bool isq = u.pn < 8; const float sc = isq ? qscale : 1.0f; const int ldc = isq ? 2048 : 512;
            bf16_t* base = isq ? Qb : Kb; const int col0 = (isq ? u.pn : u.pn - 8) * BM + wc * 32 + 8 * fq;
#pragma unroll
            for (int ai = 0; ai < 2; ++ai)
#pragma unroll
                for (int m = 0; m < 4; ++m) { bf16_t* rowp = base + (size_t)(row0 + ai * HALF + m * 16) * ldc + col0;
#pragma unroll
                    for (int bj = 0; bj < 2; ++bj) { const f32x4 v0 = acc[ai][bj][m][0] * sc, v1 = acc[ai][bj][m][1] * sc;
                        u32x4 w; w.x = cvt_pk_bf16(v0[0], v0[1]); w.y = cvt_pk_bf16(v0[2], v0[3]); w.z = cvt_pk_bf16(v1[0], v1[1]); w.w = cvt_pk_bf16(v1[2], v1[3]);
                        *(u32x4*)(rowp + bj * HALF) = w; } }
        } else {
            const int col0 = (u.pn - 10) * BM + wc * 32 + 8 * fq;
#pragma unroll
            for (int ai = 0; ai < 2; ++ai)
#pragma unroll
                for (int m = 0; m < 4; ++m) { const int row = row0 + ai * HALF + m * 16; const int b = row >> 11, s = row & 2047;
#pragma unroll
                    for (int bj = 0; bj < 2; ++bj)
#pragma unroll
                        for (int n = 0; n < 2; ++n)
#pragma unroll
                            for (int j = 0; j < 4; ++j) { const int c = col0 + bj * HALF + 4 * n + j; Vt[((size_t)b * 512 + c) * S_ + s] = f2bf(acc[ai][bj][m][n][j]); } }
        }
    }
};

DI void conv_t(const float* __restrict__ src, int ldsrc, int col0, int K, int N, const float* __restrict__ gain, bf16_t* __restrict__ dst, bool glu) {
    const size_t total = (size_t)N * (K / 8), stride = (size_t)gridDim.x * 512;
    for (size_t idx = (size_t)lnd_bid() * 512 + lnd_tid(); idx < total; idx += stride) {
        const int n = (int)(idx % (size_t)N), k0 = (int)(idx / (size_t)N) * 8;
        int sc = n; if (glu) { const int pn = n >> 8, bj = (n >> 7) & 1, jj = n & 127; sc = bj * 2048 + pn * 128 + jj; }
        const float* s = src + (size_t)k0 * ldsrc + col0 + sc;
        float v[8];
#pragma unroll
        for (int j = 0; j < 8; ++j) v[j] = s[(size_t)j * ldsrc];
        if (gain) {
#pragma unroll
            for (int j = 0; j < 8; ++j) v[j] *= gain[k0 + j]; }
        u32x4 w; w.x = cvt_pk_bf16(v[0], v[1]); w.y = cvt_pk_bf16(v[2], v[3]); w.z = cvt_pk_bf16(v[4], v[5]); w.w = cvt_pk_bf16(v[6], v[7]);
        *(u32x4*)(dst + (size_t)n * K + k0) = w;
    }
}

template <int MODE> DI void row_phase(const float* __restrict__ x, float* __restrict__ h, const float* __restrict__ t32, const float* __restrict__ gain, bf16_t* __restrict__ xn) {
    const int tid = lnd_tid(); const int wid = tid >> 6, lane = tid & 63;
    for (int row = lnd_bid() * 8 + wid; row < MT; row += gridDim.x * 8) {
        const size_t ro = (size_t)row * D_;
        f32x4 hv[8];
        if (MODE == 0) {
#pragma unroll
            for (int it = 0; it < 8; ++it) hv[it] = *(const f32x4*)(x + ro + it * 256 + lane * 4);
        } else {
#pragma unroll
            for (int it = 0; it < 8; ++it) hv[it] = *(const f32x4*)(h + ro + it * 256 + lane * 4);
        }
        if (MODE == 1 || MODE == 2) {
            f32x4 tv[8]; float ss = 0.f;
#pragma unroll
            for (int it = 0; it < 8; ++it) { tv[it] = *(const f32x4*)(t32 + ro + it * 256 + lane * 4); ss += tv[it][0] * tv[it][0] + tv[it][1] * tv[it][1] + tv[it][2] * tv[it][2] + tv[it][3] * tv[it][3]; }
            ss = wave_sum(ss, lane); const float r1 = rsqrtf(ss * (1.0f / D_) + 1e-6f);
#pragma unroll
            for (int it = 0; it < 8; ++it) { const f32x4 g = *(const f32x4*)(gain + it * 256 + lane * 4);
#pragma unroll
                for (int j = 0; j < 4; ++j) hv[it][j] += tv[it][j] * r1 * g[j]; }
        }
        if (MODE != 3) {
#pragma unroll
            for (int it = 0; it < 8; ++it) *(f32x4*)(h + ro + it * 256 + lane * 4) = hv[it];
        }
        float r2 = 1.0f;
        if (MODE != 2) { float ss = 0.f;
#pragma unroll
            for (int it = 0; it < 8; ++it) ss += hv[it][0] * hv[it][0] + hv[it][1] * hv[it][1] + hv[it][2] * hv[it][2] + hv[it][3] * hv[it][3];
            ss = wave_sum(ss, lane); r2 = rsqrtf(ss * (1.0f / D_) + 1e-6f); }
#pragma unroll
        for (int it = 0; it < 8; ++it) { u32x2 w; w.x = cvt_pk_bf16(hv[it][0] * r2, hv[it][1] * r2); w.y = cvt_pk_bf16(hv[it][2] * r2, hv[it][3] * r2);
            *(u32x2*)(xn + ro + it * 256 + lane * 4) = w; }
    }
}
DI void conv_p(const float* __restrict__ src, bf16_t* __restrict__ dst) {
    const size_t total = (size_t)MT * PLE / 4, stride = (size_t)gridDim.x * 512;
    for (size_t i = (size_t)lnd_bid() * 512 + lnd_tid(); i < total; i += stride) { const f32x4 v = *(const f32x4*)(src + i * 4); u32x2 w; w.x = cvt_pk_bf16(v[0], v[1]); w.y = cvt_pk_bf16(v[2], v[3]); *(u32x2*)(dst + i * 4) = w; }
}

DI void sincos_pi(float r, float& s, float& c) {
    const float y = r * 0.25f, y2 = y * y;
    float sp = y * (1.0f + y2 * (-1.6666667e-1f + y2 * (8.3333333e-3f + y2 * (-1.9841270e-4f + y2 * 2.7557319e-6f))));
    float cp = 1.0f + y2 * (-0.5f + y2 * (4.1666667e-2f + y2 * (-1.3888889e-3f + y2 * (2.4801587e-5f + y2 * -2.7557319e-7f))));
    const float s2 = 2.f * sp * cp, c2 = 1.f - 2.f * sp * sp;
    s = 2.f * s2 * c2; c = 1.f - 2.f * s2 * s2;
}
DI void scan_phase(const float* a_re_, const float* a_im_, const float* log_step_, const float* b_re_, const float* b_im_, const float* c_re_, const float* c_im_, const float* d_, int j, const bf16_t* __restrict__ U, bf16_t* __restrict__ Y) {
    const int tid = lnd_tid(); const int wid = tid >> 6, lane = tid & 63;
    for (int item = lnd_bid() * 8 + wid; item < B_ * NG; item += gridDim.x * 8) {
        const int b = item / NG, g = item % NG, p = lane;
        const float ar = a_re_[((size_t)j * NG + g) * NP + p], ai = a_im_[((size_t)j * NG + g) * NP + p];
        const float dt = expf(log_step_[j * NG + g]);
        const float mag = expf(ar * dt);
        const float ang = ai * dt;
        const float kk = rintf(ang * 0.15915494309189535f);
        float rr = fmaf(-kk, 6.28125f, ang); rr = fmaf(-kk, 0.0019353071795864769f, rr);
        float sn, cs; sincos_pi(rr, sn, cs);
        const float lbr = mag * cs, lbi = mag * sn;
        const float den = ar * ar + ai * ai, nr = lbr - 1.0f;
        const float fr = (nr * ar + lbi * ai) / den, fi = (lbi * ar - nr * ai) / den;
        float bbr[16], bbi[16], cr[16], ci[16];
#pragma unroll
        for (int hh = 0; hh < 16; ++hh) {
            const float br = b_re_[(((size_t)j * NG + g) * NP + p) * 16 + hh], bi = b_im_[(((size_t)j * NG + g) * NP + p) * 16 + hh];
            bbr[hh] = fr * br - fi * bi; bbi[hh] = fr * bi + fi * br;
            cr[hh] = c_re_[(((size_t)j * NG + g) * 16 + hh) * NP + p]; ci[hh] = c_im_[(((size_t)j * NG + g) * 16 + hh) * NP + p];
        }
        const float dsk = d_[j * D_ + g * 16 + (lane & 15)];
        const size_t base = (size_t)b * S_ * D_ + g * 16 + (lane & 15) + (size_t)(lane >> 4) * D_;
        float xr = 0.f, xi = 0.f;
        float unext = bf2f(U[base]);
        for (int t0 = 0; t0 < S_; t0 += 4) {
            const float uv = unext;
            if (t0 + 4 < S_) unext = bf2f(U[base + (size_t)(t0 + 4) * D_]);
            float vals[64];
#pragma unroll
            for (int k = 0; k < 4; ++k) {
                float bur = 0.f, bui = 0.f;
#pragma unroll
                for (int hh = 0; hh < 16; ++hh) { const float s = __builtin_bit_cast(float, __builtin_amdgcn_readlane(__builtin_bit_cast(int, uv), k * 16 + hh)); bur = fmaf(bbr[hh], s, bur); bui = fmaf(bbi[hh], s, bui); }
                const float nxr = lbr * xr - lbi * xi + bur, nxi = lbr * xi + lbi * xr + bui;
                xr = nxr; xi = nxi;
#pragma unroll
                for (int hh = 0; hh < 16; ++hh) vals[k * 16 + hh] = cr[hh] * xr - ci[hh] * xi;
            }
#pragma unroll
            for (int sft = 5; sft >= 0; --sft) {
                const int half = 1 << sft; const bool bit = (lane >> sft) & 1;
#pragma unroll
                for (int i = 0; i < half; ++i) {
                    const float keep = bit ? vals[i + half] : vals[i], send = bit ? vals[i] : vals[i + half];
                    vals[i] = keep + shx(send, lane, half);
                }
            }
            const float yv = vals[0] + dsk * uv;
            const float a2 = 1.5957691216057308f * (yv + 0.044715f * yv * yv * yv);
            const float gl = yv / (1.0f + __expf(-a2));
            Y[base + (size_t)t0 * D_] = f2bf(gl);
        }
    }
}

constexpr int KROW = 272, VROW = 80, KBUF = 32 * KROW, VBUF = 128 * VROW;
DI void attn_phase(PG8_LAS unsigned char* lds, const bf16_t* __restrict__ Q, const bf16_t* __restrict__ Kb, const bf16_t* __restrict__ Vt, bf16_t* __restrict__ O) {
    const int tid = lnd_tid(), bid = lnd_bid(), wid = tid >> 6, lane = tid & 63, r = lane & 31, hh = lane >> 5, hql = wid & 3, wh = wid >> 2;
    PG8_LAS unsigned char* kbuf = lds; PG8_LAS unsigned char* vbuf = lds + 2 * KBUF;
    for (int pi = 0; pi < 4; ++pi) {
        const int PP = bid * 4 + pi; if (PP >= B_ * 4 * 16) break;
        const int pq = PP & 15, hk = (PP >> 4) & 3, b = PP >> 6;
        for (int hf = 0; hf < 2; ++hf) {
            const int qb = hf ? 31 - pq : pq, q0 = qb * 64;
            const int t = q0 + 32 * wh + r; const size_t token = (size_t)b * S_ + t; const int hq = hk * 4 + hql;
            bf16x8 qf[8];
#pragma unroll
            for (int st = 0; st < 8; ++st) qf[st] = *(const bf16x8*)(Q + token * D_ + hq * 128 + st * 16 + hh * 8);
            f32x16 oacc[4];
#pragma unroll
            for (int mt = 0; mt < 4; ++mt)
#pragma unroll
                for (int i = 0; i < 16; ++i) oacc[mt][i] = 0.f;
            float carry = 0.f; float negbig = -1.0e30f; asm volatile("" : "+v"(negbig));
            const int ntiles = 2 * qb + 2, mydiag = 2 * qb + wh;
            const bf16_t* gK = Kb + ((size_t)b * S_ + (tid >> 4)) * 512 + hk * 128 + (tid & 15) * 8;
            const bf16_t* gV = Vt + ((size_t)(b * 4 + hk) * 128 + (tid >> 2)) * S_ + (tid & 3) * 8;
            const int kw = (tid >> 4) * KROW + (tid & 15) * 16, vw = (tid >> 2) * VROW + (tid & 3) * 8;
            u32x4 rk = *(const u32x4*)(gK + (size_t)(ntiles - 1) * 32 * 512), rv = *(const u32x4*)(gV + (ntiles - 1) * 32);
            *(PG8_LAS u32x4*)(kbuf + kw) = rk;
            *(PG8_LAS u32x2*)(vbuf + vw) = (u32x2){rv.x, rv.y}; *(PG8_LAS u32x2*)(vbuf + vw + 32) = (u32x2){rv.z, rv.w};
            __syncthreads();
            for (int it = 0; it < ntiles; ++it) {
                const int kt = ntiles - 1 - it, cur = it & 1; const bool more = it + 1 < ntiles;
                if (more) { rk = *(const u32x4*)(gK + (size_t)(kt - 1) * 32 * 512); rv = *(const u32x4*)(gV + (kt - 1) * 32); }
                if (kt <= mydiag) {
                    f32x16 sacc;
#pragma unroll
                    for (int i = 0; i < 16; ++i) sacc[i] = 0.f;
                    PG8_LAS unsigned char* kp = kbuf + cur * KBUF + r * KROW + hh * 16;
#pragma unroll
                    for (int st = 0; st < 8; ++st) { const bf16x8 kf = *(const PG8_LAS bf16x8*)(kp + st * 32); sacc = __builtin_amdgcn_mfma_f32_32x32x16_bf16(kf, qf[st], sacc, 0, 0, 0); }
                    const bool diag = (kt == mydiag);
                    float sp[16];
#pragma unroll
                    for (int i = 0; i < 16; ++i) {
                        const int cw = (i & 3) + 8 * (i >> 2) + 4 * hh; const bool valid = !diag || (cw < r);
                        const float z = sacc[i]; const float e = __builtin_amdgcn_exp2f(-fabsf(z));
                        const float s = fmaxf(z, 0.f) + __builtin_amdgcn_logf(1.0f + e);
                        sp[i] = valid ? s : 0.f; sacc[i] = valid ? z : negbig;
                    }
                    float gs[4], pg[4];
#pragma unroll
                    for (int g = 0; g < 4; ++g) { gs[g] = (sp[4 * g] + sp[4 * g + 1]) + (sp[4 * g + 2] + sp[4 * g + 3]); pg[g] = shx(gs[g], lane, 32); }
                    float T[4]; T[3] = 0.f; T[2] = gs[3] + pg[3]; T[1] = T[2] + gs[2] + pg[2]; T[0] = T[1] + gs[1] + pg[1];
                    const float total = T[0] + gs[0] + pg[0];
                    float w[16];
#pragma unroll
                    for (int g = 0; g < 4; ++g) { float run = carry + T[g] + (hh == 0 ? pg[g] : 0.f);
#pragma unroll
                        for (int jj = 3; jj >= 0; --jj) { const int i = 4 * g + jj; w[i] = __builtin_amdgcn_exp2f(sacc[i] - sp[i] - run); run += sp[i]; } }
                    carry += total;
                    u32x4 p0, p1;
                    p0.x = cvt_pk_bf16(w[0], w[1]); p0.y = cvt_pk_bf16(w[2], w[3]); p0.z = cvt_pk_bf16(w[4], w[5]); p0.w = cvt_pk_bf16(w[6], w[7]);
                    p1.x = cvt_pk_bf16(w[8], w[9]); p1.y = cvt_pk_bf16(w[10], w[11]); p1.z = cvt_pk_bf16(w[12], w[13]); p1.w = cvt_pk_bf16(w[14], w[15]);
                    const bf16x8 pb0 = __builtin_bit_cast(bf16x8, p0), pb1 = __builtin_bit_cast(bf16x8, p1);
                    PG8_LAS unsigned char* vp = vbuf + cur * VBUF + r * VROW + hh * 32;
#pragma unroll
                    for (int mt = 0; mt < 4; ++mt) {
                        const bf16x8 va = *(const PG8_LAS bf16x8*)(vp + mt * 32 * VROW), vb = *(const PG8_LAS bf16x8*)(vp + mt * 32 * VROW + 16);
                        oacc[mt] = __builtin_amdgcn_mfma_f32_32x32x16_bf16(va, pb0, oacc[mt], 0, 0, 0);
                        oacc[mt] = __builtin_amdgcn_mfma_f32_32x32x16_bf16(vb, pb1, oacc[mt], 0, 0, 0);
                    }
                }
                if (more) {
                    *(PG8_LAS u32x4*)(kbuf + (cur ^ 1) * KBUF + kw) = rk;
                    *(PG8_LAS u32x2*)(vbuf + (cur ^ 1) * VBUF + vw) = (u32x2){rv.x, rv.y}; *(PG8_LAS u32x2*)(vbuf + (cur ^ 1) * VBUF + vw + 32) = (u32x2){rv.z, rv.w};
                }
                __syncthreads();
            }
            bf16_t* op = O + token * D_ + hq * 128 + 4 * hh;
#pragma unroll
            for (int mt = 0; mt < 4; ++mt)
#pragma unroll
                for (int g = 0; g < 4; ++g) { u32x2 w2; w2.x = cvt_pk_bf16(oacc[mt][4 * g], oacc[mt][4 * g + 1]); w2.y = cvt_pk_bf16(oacc[mt][4 * g + 2], oacc[mt][4 * g + 3]);
                    *(u32x2*)(op + mt * 32 + g * 8) = w2; }
        }
    }
}

#define GRID_SYNC() do { XcdBarrier b2_ = bar; asm volatile("" : "+s"(b2_.bar)); xcd_barrier(b2_); } while (0)
#ifndef NO_GEMM
#define GEMMCALL gemm_phase(lds, g, S, E, nullptr);
#else
#define GEMMCALL E(*(const f32x4 (*)[2][2][4][2])nullptr, Unit{0,0},0,0,0,0);
#endif
__global__ void __launch_bounds__(512, 2) mega(Params P_unused) {
#define P (*(const __attribute__((address_space(4))) Params*)__builtin_amdgcn_kernarg_segment_ptr())
    extern __shared__ __attribute__((aligned(16))) unsigned char shm[];
    PG8_LAS unsigned char* lds = (PG8_LAS unsigned char*)shm;
    volatile LAS unsigned* xbw = (volatile LAS unsigned*)(lds + LDS_GEMM);
    if (threadIdx.x == 0) { xbw[0] = 0u; xbw[1] = 0u; xbw[2] = 0u; xbw[3] = 0u; }
    __syncthreads();
    XcdBarrier bar = xcd_barrier_post(P.bar, xbw);
    const int G = gridDim.x, c = blockIdx.x;
    const float qscale = 0.08838834764831845f * 1.4426950408889634f;

#pragma unroll 1
    for (int w = 0; w < 26; ++w) {
        const float* src; const float* gain = nullptr; bf16_t* dst; int ldsrc = D_, K = D_, N = D_; bool glu = false;
        if (w < 2)       { src = P.ssm_w_in + (size_t)w * D_ * D_; gain = P.a_norm_pre + w * D_; dst = P.wb + W_IN0 + (size_t)w * D_ * D_; }
        else if (w < 4)  { const int j = w - 2; src = P.ssm_w_glu + (size_t)j * D_ * 2 * D_; ldsrc = 2 * D_; N = 2 * D_; dst = P.wb + W_GLU0 + (size_t)j * 2 * D_ * D_; glu = true; }
        else if (w < 6)  { const int j = w - 4; src = P.w_o + (size_t)j * D_ * D_; dst = P.wb + W_O0 + (size_t)j * D_ * D_; }
        else if (w == 6) { src = P.w_q; gain = P.b_norm_pre; dst = P.wb + W_QKV0; }
        else if (w == 7) { src = P.w_k; ldsrc = 512; N = 512; gain = P.kv_norm; dst = P.wb + W_QKV0 + 2048ull * D_; }
        else if (w == 8) { src = P.w_v; ldsrc = 512; N = 512; gain = P.kv_norm; dst = P.wb + W_QKV0 + 2560ull * D_; }
        else if (w == 9) { src = P.w_q + (size_t)D_ * D_; gain = P.b_norm_pre + D_; dst = P.wb + W_Q1; }
        else if (w < 14) { const int i = w - 10; src = P.mlp_w1 + (size_t)i * D_ * DFF; ldsrc = DFF; N = DFF; gain = P.mlp_norm_pre + i * D_; dst = P.wb + W_10 + (size_t)i * DFF * D_; }
        else if (w < 18) { const int i = w - 14; src = P.mlp_w2 + (size_t)i * DFF * D_; K = DFF; dst = P.wb + W_20 + (size_t)i * DFF * D_; }
        else if (w < 22) { const int i = w - 18; src = P.ple_w + (size_t)i * PLE * D_; K = PLE; dst = P.wb + W_PLE0 + (size_t)i * D_ * PLE; }
        else             { const int i = w - 22; src = P.ple_gate + (size_t)i * D_ * D_; dst = P.wb + W_GATE0 + (size_t)i * D_ * D_; }
        conv_t(src, ldsrc, 0, K, N, gain, dst, glu);
    }
    row_phase<0>(P.x, P.h, nullptr, nullptr, P.xn);
    GRID_SYNC();

#pragma unroll 1
    for (int layer = 0; layer < 4; ++layer) {
        if (layer < 2) {
            const int j = layer;
            { Gemm g{P.xn, P.wb + W_IN0 + (size_t)j * D_ * D_, MT, D_, D_}; StaticOrder S; S.init(g.M, g.N, G, lnd_bid()); EpiB16<0> E{P.big, D_}; GEMMCALL }
            GRID_SYNC();
#ifndef NO_SCAN
            scan_phase(P.ssm_a_re, P.ssm_a_im, P.ssm_log_step, P.ssm_b_re, P.ssm_b_im, P.ssm_c_re, P.ssm_c_im, P.ssm_d, j, P.big, P.xn);
#endif
            GRID_SYNC();
            { Gemm g{P.xn, P.wb + W_GLU0 + (size_t)j * 2 * D_ * D_, MT, 2 * D_, D_}; StaticOrder S; S.init(g.M, g.N, G, lnd_bid()); EpiGlu E{P.t32}; GEMMCALL }
            GRID_SYNC();
            row_phase<1>(nullptr, P.h, P.t32, P.a_norm_post + j * D_, P.xn);
            GRID_SYNC();
        } else {
            const int j = layer - 2;
            if (j == 0) { Gemm g{P.xn, P.wb + W_QKV0, MT, 3072, D_}; StaticOrder S; S.init(g.M, g.N, G, lnd_bid()); EpiQKV E{P.big, P.kb, P.vt, qscale}; GEMMCALL }
            else        { Gemm g{P.xn, P.wb + W_Q1, MT, D_, D_}; StaticOrder S; S.init(g.M, g.N, G, lnd_bid()); EpiQKV E{P.big, P.kb, P.vt, qscale}; GEMMCALL }
            GRID_SYNC();
#ifndef NO_ATTN
            attn_phase(lds, P.big, P.kb, P.vt, P.xn);
#endif
            GRID_SYNC();
            { Gemm g{P.xn, P.wb + W_O0 + (size_t)j * D_ * D_, MT, D_, D_}; StaticOrder S; S.init(g.M, g.N, G, lnd_bid()); EpiF32s E{P.t32, D_}; GEMMCALL }
            GRID_SYNC();
            row_phase<1>(nullptr, P.h, P.t32, P.b_norm_post + j * D_, P.xn);
            GRID_SYNC();
        }
#pragma unroll 1
        for (int ch = 0; ch < MT / MCH; ++ch) {
            { Gemm g{P.xn + (size_t)ch * MCH * D_, P.wb + W_10 + (size_t)layer * DFF * D_, MCH, DFF, D_}; StaticOrder S; S.init(g.M, g.N, G, lnd_bid()); EpiB16<1> E{P.big, DFF}; GEMMCALL }
            GRID_SYNC();
            { Gemm g{P.big, P.wb + W_20 + (size_t)layer * DFF * D_, MCH, D_, DFF}; StaticOrder S; S.init(g.M, g.N, G, lnd_bid()); EpiF32s E{P.t32 + (size_t)ch * MCH * D_, D_}; GEMMCALL }
            GRID_SYNC();
        }
        row_phase<2>(nullptr, P.h, P.t32, P.mlp_norm_post + layer * D_, P.xn);
        conv_p(P.p + (size_t)layer * MT * PLE, P.pb);
        GRID_SYNC();
        { Gemm g{P.xn, P.wb + W_GATE0 + (size_t)layer * D_ * D_, MT, D_, D_}; StaticOrder S; S.init(g.M, g.N, G, lnd_bid()); EpiF32s E{P.t32, D_}; GEMMCALL }
        GRID_SYNC();
        { Gemm g{P.pb, P.wb + W_PLE0 + (size_t)layer * D_ * PLE, MT, D_, PLE}; StaticOrder S; S.init(g.M, g.N, G, lnd_bid()); EpiPle E{P.h, P.t32}; GEMMCALL }
        GRID_SYNC();
        if (layer < 3) { row_phase<3>(nullptr, P.h, nullptr, nullptr, P.xn); GRID_SYNC(); }
    }
}
#undef P

extern "C" void kernel_launch(void* const* d_in, const int* in_sizes, int n_in, void* d_out, int out_size, void* d_ws, size_t ws_size, hipStream_t stream) {
    (void)in_sizes; (void)n_in; (void)out_size;
    if (ws_size < WS_NEED) { fprintf(stderr, "workspace too small: %zu < %zu\n", ws_size, (size_t)WS_NEED); return; }
    static bool attr_set = false;
    if (!attr_set) { hipFuncSetAttribute((const void*)mega, hipFuncAttributeMaxDynamicSharedMemorySize, LDS_TOTAL); attr_set = true; }
    unsigned char* ws = (unsigned char*)d_ws;
    Params P{};
    const float** f = (const float**)&P;
    for (int i = 0; i < 27; ++i) f[i] = (const float*)d_in[i];
    P.h = (float*)d_out; P.bar = (unsigned*)(ws + OFF_BAR); P.wb = (bf16_t*)(ws + OFF_WB); P.xn = (bf16_t*)(ws + OFF_XN); P.big = (bf16_t*)(ws + OFF_BIG);
    P.t32 = (float*)(ws + OFF_T32); P.kb = (bf16_t*)(ws + OFF_KB); P.vt = (bf16_t*)(ws + OFF_VT); P.pb = (bf16_t*)(ws + OFF_PB);
    hipMemsetAsync(P.bar, 0, XCD_BAR_WORDS * sizeof(unsigned), stream);
    int dev = 0, cus = 256; hipGetDevice(&dev); hipDeviceGetAttribute(&cus, hipDeviceAttributeMultiprocessorCount, dev);
    hipLaunchKernelGGL(mega, dim3(cus), dim3(512), LDS_TOTAL, stream, P);
}
```

```cpp
#include <hip/hip_runtime.h>
#include <cstdio>
#include <cstdint>
#include <cstdlib>
#include <vector>

#define XB_TMO      128
#define XB_XCNT(j)  (256  + 64 * (j))
#define XB_XSUB(j)  (1280 + 64 * (j))
#define XB_XGEN(j)  (2304 + 64 * (j))
#define XB_TOP      3328
#define XB_TOPGEN   3392
#define XCD_BAR_WORDS 3456
#define XB_SPIN_CAP (1u << 18)
#define LAS __attribute__((address_space(3)))

__device__ __forceinline__ unsigned xb_ld(unsigned* p)              { return __hip_atomic_load(p, __ATOMIC_RELAXED, __HIP_MEMORY_SCOPE_AGENT); }
__device__ __forceinline__ unsigned xb_add(unsigned* p, unsigned v) { return __hip_atomic_fetch_add(p, v, __ATOMIC_RELAXED, __HIP_MEMORY_SCOPE_AGENT); }
__device__ __forceinline__ unsigned xb_xcc_id() { return (unsigned)__builtin_amdgcn_s_getreg((3 << 11) | 20) & 0xFu; }
#define XB_SPIN(cond, bar) do { unsigned _sp = 0; while (cond) { __builtin_amdgcn_s_sleep(1); \
    if ((++_sp & 255u) == 0u) { if (xb_ld(&(bar)[XB_TMO])) break; if (_sp > XB_SPIN_CAP) { atomicAdd(&(bar)[XB_TMO], 1u); break; } } } } while (0)

struct XcdBarrier {
    unsigned* bar; unsigned x;
    volatile LAS unsigned* st;
};

__device__ __forceinline__ XcdBarrier xcd_barrier_post(unsigned* bar, volatile LAS unsigned* st) {
    XcdBarrier b; b.bar = bar; b.x = xb_xcc_id(); b.st = st;
    if (threadIdx.x == 0) (void)xb_add(&bar[XB_XCNT(b.x)], 1u);
    return b;
}
__device__ __forceinline__ void xcd_barrier_complete(unsigned* bar, unsigned x, unsigned& nloc, unsigned& nx) {
    const unsigned G = gridDim.x * gridDim.y * gridDim.z;
    unsigned sum, cnt, mine, sp = 0u;
    for (;;) {
        sum = 0u; cnt = 0u; mine = 0u;
#pragma unroll
        for (unsigned j = 0; j < 16; ++j) { const unsigned c = xb_ld(&bar[XB_XCNT(j)]); sum += c; cnt += (c > 0u) ? 1u : 0u; mine = (j == x) ? c : mine; }
        if (sum == G) break;
        __builtin_amdgcn_s_sleep(1);
        if ((++sp & 255u) == 0u) { if (xb_ld(&bar[XB_TMO])) break; if (sp > XB_SPIN_CAP) { atomicAdd(&bar[XB_TMO], 1u); break; } }
    }
    nloc = mine > 0u ? mine : 1u; nx = cnt > 0u ? cnt : 1u;
}

__device__ __forceinline__ void xcd_barrier(const XcdBarrier& b) {
    asm volatile("s_waitcnt vmcnt(0)" ::: "memory");
    __syncthreads();
    if (threadIdx.x == 0) {
        unsigned* bar = b.bar;
        __builtin_amdgcn_s_waitcnt(0);
        unsigned nloc = b.st[0], nx = b.st[1];
        if (nloc == 0u) { xcd_barrier_complete(bar, b.x, nloc, nx); b.st[0] = nloc; b.st[1] = nx; }
        const unsigned old = xb_add(&bar[XB_XSUB(b.x)], 1u);
        const unsigned gen = old / nloc;
        if (old + 1u == (gen + 1u) * nloc) {
            __builtin_amdgcn_fence(__ATOMIC_RELEASE, "agent");
            asm volatile("s_waitcnt vmcnt(0)" ::: "memory");
            const unsigned og = xb_add(&bar[XB_TOP], 1u);
            const unsigned tg = og / nx;
            if (og + 1u == (tg + 1u) * nx) xb_add(&bar[XB_TOPGEN], 1u);
            else XB_SPIN(xb_ld(&bar[XB_TOPGEN]) == tg, bar);
            __builtin_amdgcn_fence(__ATOMIC_ACQUIRE, "agent");
            xb_add(&bar[XB_XGEN(b.x)], 1u);
            asm volatile("s_waitcnt vmcnt(0)" ::: "memory");
        } else {
            XB_SPIN(xb_ld(&bar[XB_XGEN(b.x)]) == gen, bar);
            __builtin_amdgcn_fence(__ATOMIC_ACQUIRE, "agent");
            asm volatile("s_waitcnt vmcnt(0)" ::: "memory");
        }
    }
    __syncthreads();
}
namespace pg8 {
#define PG8_LAS __attribute__((address_space(3)))
typedef unsigned short bf16_t;
typedef short bf16x8 __attribute__((ext_vector_type(8)));
typedef float f32x4 __attribute__((ext_vector_type(4)));
typedef unsigned u32x4 __attribute__((ext_vector_type(4)));
constexpr int BM = 256, BK = 64, HALF = 128, HTB = HALF * BK * 2  , STAGE_BYTES = 8 * HTB, NXCD = 8, WGM = 8;

__host__ __device__ __forceinline__ int lds_byte(int r, int c) { const int st = (r >> 4) * 2 + (c >> 5), rr = r & 15, cc = c & 31, ob = rr * 64 + cc * 2; return st * 1024 + (ob ^ (((ob >> 9) & 1) << 5)); }
__host__ __device__ __forceinline__ void stage_rc(int b, int& R, int& C) { const int st = b / 1024, sb = b % 1024, swz = sb ^ (((sb >> 9) & 1) << 5); R = (st >> 1) * 16 + swz / 64; C = (st & 1) * 32 + (swz % 64) / 2; }
__host__ __device__ __forceinline__ int perm32(int rho) { const int n = rho >> 4, i = rho & 15; return 8 * (i >> 2) + 4 * n + (i & 3); }

struct Unit { int pm, pn; };
struct Gemm { const bf16_t* A; const bf16_t* Bt; int M, N, K; };
struct StaticOrder {
    int nM, nN, nwg, G, c;
    __host__ __device__ void init(int M, int N, int G_, int c_) { nM = M / BM; nN = N / BM; nwg = nM * nN; G = G_; c = c_; }
    __host__ __device__ bool next(int i, Unit& u) const {
        const int L = i * G + c; if (L >= nwg) return false;
        int wgid = (int)L; { const int q = nwg / NXCD, r = nwg % NXCD, xcd = wgid % NXCD, off = wgid / NXCD; wgid = (xcd < r ? xcd * (q + 1) : r * (q + 1) + (xcd - r) * q) + off; }
        const int nig = WGM * nN, gid = wgid / nig, fm = gid * WGM, gsz = (nM - fm) < WGM ? (nM - fm) : WGM;
        u.pm = fm + ((wgid % nig) % gsz); u.pn = (wgid % nig) / gsz; return true;
    }
    __device__ __forceinline__ void a_ready(const Unit&) const {}
    __device__ __forceinline__ void done(const Unit&) const {}
};
__device__ __forceinline__ unsigned cvt_pk_bf16(float lo, float hi) { unsigned r; asm volatile("v_cvt_pk_bf16_f32 %0, %1, %2" : "=v"(r) : "v"(lo), "v"(hi)); return r; }
template <class Epi, class Sched, bool STAMP = false>
__device__ __forceinline__ void gemm_phase(PG8_LAS unsigned char* lds, const Gemm g, const Sched& S, const Epi& E, unsigned long long* stamps) {
    int tid_l = threadIdx.x; asm volatile("" : "+v"(tid_l));
    const int tid = tid_l, wid = __builtin_amdgcn_readfirstlane(tid >> 6), lane = tid & 63, wr = wid >> 2, wc = wid & 3, fr = lane & 15, fq = lane >> 4;
    const int K = g.K, nt = K / BK;
    int ts_lo = 0, ts_hi = 0, nts = 0; const unsigned long long rt_entry = STAMP ? (unsigned long long)wall_clock64() : 0ull;
#define PG8_STAMP() do { if (STAMP && wid == 0 && nts < 64) { const unsigned long long _c = (unsigned long long)clock64(); \
        ts_lo = (lane == nts) ? (int)(unsigned)_c : ts_lo; ts_hi = (lane == nts) ? (int)(unsigned)(_c >> 32) : ts_hi; ++nts; } } while (0)
    PG8_STAMP();
    unsigned voffA[2], voffB[2];
#pragma unroll
    for (int i = 0; i < 2; ++i) { int R, C; stage_rc(tid * 16 + i * 8192, R, C); const int Rb = Epi::PERM ? ((R & ~31) + perm32(R & 31)) : R;
        voffA[i] = (unsigned)(R * K + C) * 2u; voffB[i] = (unsigned)(Rb * K + C) * 2u; }
    const size_t kstep = (size_t)(BK * 2);
    const size_t hstep = (size_t)HALF * K * 2;
    const size_t tstep = 2 * hstep;
    const unsigned ldsw = (unsigned)wid * 1024u;
    const int aoff = lds_byte(wr * 64 + fr, fq * 8), boff = lds_byte(wc * 32 + fr, fq * 8);
#define PG8_SA(b, h) (((b) * 2 + (h)) * HTB)
#define PG8_SB(b, h) ((4 + (b) * 2 + (h)) * HTB)
#define PG8_STAGE(bufoff, gbase, voff) do { _Pragma("unroll") for (int _i = 0; _i < 2; ++_i) \
        __builtin_amdgcn_global_load_lds((const unsigned*)((const char*)(gbase) + (voff)[_i]), (PG8_LAS unsigned*)(lds + (bufoff) + ldsw + _i * 8192), 16, 0, 0); } while (0)
#define PG8_LDA(dst, b, h) do { _Pragma("unroll") for (int m = 0; m < 4; ++m) _Pragma("unroll") for (int k = 0; k < 2; ++k) dst[m][k] = *(const PG8_LAS bf16x8*)(lds + PG8_SA(b, h) + aoff + m * 2048 + k * 1024); } while (0)
#define PG8_LDB(dst, b, h) do { _Pragma("unroll") for (int n = 0; n < 2; ++n) _Pragma("unroll") for (int k = 0; k < 2; ++k) dst[n][k] = *(const PG8_LAS bf16x8*)(lds + PG8_SB(b, h) + boff + n * 2048 + k * 1024); } while (0)
#define PG8_MMA(ai, bj, At, Bt) do { __builtin_amdgcn_s_setprio(1); _Pragma("unroll") for (int m = 0; m < 4; ++m) _Pragma("unroll") for (int n = 0; n < 2; ++n) _Pragma("unroll") for (int k = 0; k < 2; ++k) \
        acc[ai][bj][m][n] = __builtin_amdgcn_mfma_f32_16x16x32_bf16(Bt[n][k], At[m][k], acc[ai][bj][m][n], 0, 0, 0); __builtin_amdgcn_s_setprio(0); } while (0)
#define PG8_WAIT_V(n) asm volatile("s_waitcnt vmcnt(" #n ")" ::: "memory")
#define PG8_WAIT_L(n) asm volatile("s_waitcnt lgkmcnt(" #n ")" ::: "memory")
#define PG8_BAR __builtin_amdgcn_s_barrier()
#define PG8_SCHED __builtin_amdgcn_sched_barrier(0)
    Unit cur, nxt; int ui = 0;
    if (!S.next(0, cur)) return;
    f32x4 acc[2][2][4][2];
#pragma unroll
    for (int a = 0; a < 2; ++a)
#pragma unroll
        for (int b = 0; b < 2; ++b)
#pragma unroll
            for (int m = 0; m < 4; ++m)
#pragma unroll
                for (int n = 0; n < 2; ++n) acc[a][b][m][n] = (f32x4){0.f, 0.f, 0.f, 0.f};
    bf16x8 At[4][2], B0[2][2], B1[2][2];
    const char* cA = (const char*)g.A + (size_t)cur.pm * tstep; const char* cB = (const char*)g.Bt + (size_t)cur.pn * tstep;
    S.a_ready(cur);
    PG8_STAGE(PG8_SB(0, 0), cB, voffB); PG8_STAGE(PG8_SA(0, 0), cA, voffA); PG8_STAGE(PG8_SB(0, 1), cB + hstep, voffB); PG8_STAGE(PG8_SA(0, 1), cA + hstep, voffA);
    if (wr == 1) PG8_BAR;
    PG8_WAIT_V(4); PG8_BAR;
    PG8_STAGE(PG8_SB(1, 0), cB + kstep, voffB); PG8_STAGE(PG8_SA(1, 0), cA + kstep, voffA); PG8_STAGE(PG8_SB(1, 1), cB + hstep + kstep, voffB);
    PG8_WAIT_V(6); PG8_BAR;
    PG8_STAMP();
    for (;;) {
        const bool has_next = S.next(ui + 1, nxt);
        const char* nA = has_next ? (const char*)g.A + (size_t)nxt.pm * tstep : cA; const char* nB = has_next ? (const char*)g.Bt + (size_t)nxt.pn * tstep : cB;
        for (int t = 0; t < nt; t += 2) {
            const bool last = (t == nt - 2);
            const char* a1 = cA + (size_t)(t + 1) * kstep;
            const char* a2 = last ? nA : cA + (size_t)(t + 2) * kstep; const char* b2 = last ? nB : cB + (size_t)(t + 2) * kstep;
            const char* a3 = a2 + kstep; const char* b3 = b2 + kstep;
            if (last && has_next) S.a_ready(nxt);
            PG8_LDB(B0, 0, 0); PG8_SCHED; PG8_LDA(At, 0, 0); PG8_STAGE(PG8_SA(1, 1), a1 + hstep, voffA);
            PG8_WAIT_L(8); PG8_BAR; PG8_WAIT_L(0); PG8_MMA(0, 0, At, B0); PG8_BAR; PG8_SCHED;
            PG8_LDB(B1, 0, 1); PG8_STAGE(PG8_SB(0, 0), b2, voffB);
            PG8_BAR; PG8_WAIT_L(0); PG8_MMA(0, 1, At, B1); PG8_BAR;
            PG8_LDA(At, 0, 1); PG8_STAGE(PG8_SA(0, 0), a2, voffA);
            PG8_BAR; PG8_WAIT_L(0); PG8_MMA(1, 0, At, B0); PG8_BAR; PG8_SCHED;
            PG8_STAGE(PG8_SB(0, 1), b2 + hstep, voffB);
            PG8_WAIT_V(6); PG8_BAR; PG8_MMA(1, 1, At, B1); PG8_BAR;
            PG8_LDB(B0, 1, 0); PG8_SCHED; PG8_LDA(At, 1, 0); PG8_STAGE(PG8_SA(0, 1), a2 + hstep, voffA);
            PG8_WAIT_L(8); PG8_BAR; PG8_WAIT_L(0); PG8_MMA(0, 0, At, B0); PG8_BAR; PG8_SCHED;
            PG8_LDB(B1, 1, 1); PG8_STAGE(PG8_SB(1, 0), b3, voffB);
            PG8_BAR; PG8_WAIT_L(0); PG8_MMA(0, 1, At, B1); PG8_BAR;
            PG8_LDA(At, 1, 1); PG8_STAGE(PG8_SA(1, 0), a3, voffA);
            PG8_BAR; PG8_WAIT_L(0); PG8_MMA(1, 0, At, B0); PG8_BAR; PG8_SCHED;
            PG8_STAGE(PG8_SB(1, 1), b3 + hstep, voffB);
            PG8_WAIT_V(6); PG8_BAR; PG8_MMA(1, 1, At, B1); PG8_BAR;
        }
        PG8_STAMP();
        if constexpr (!Epi::AFTER_DRAIN) { int l2 = threadIdx.x; asm volatile("" : "+v"(l2)); l2 &= 63; E(acc, cur, wr, wc, l2 & 15, l2 >> 4); S.done(cur); }
        PG8_STAMP();
        if (!has_next) break;
#pragma unroll
        for (int a = 0; a < 2; ++a)
#pragma unroll
            for (int b = 0; b < 2; ++b)
#pragma unroll
                for (int m = 0; m < 4; ++m)
#pragma unroll
                    for (int n = 0; n < 2; ++n) acc[a][b][m][n] = (f32x4){0.f, 0.f, 0.f, 0.f};
        cur = nxt; cA = nA; cB = nB; ++ui;
    }
    PG8_WAIT_V(0);
    if (wr == 0) PG8_BAR;
    PG8_BAR;
    if constexpr (Epi::AFTER_DRAIN) { E.fused(acc, cur, wr, wc, fr, fq, lds, wid, lane); S.done(cur); }
    PG8_STAMP();
    if (STAMP && wid == 0) { stamps[lane] = lane < nts ? (((unsigned long long)(unsigned)ts_hi << 32) | (unsigned)ts_lo) : 0ull;
        if (lane == 62) stamps[62] = rt_entry; if (lane == 63) stamps[63] = (unsigned long long)wall_clock64(); }
#undef PG8_STAMP
#undef PG8_SA
#undef PG8_SB
#undef PG8_STAGE
#undef PG8_LDA
#undef PG8_LDB
#undef PG8_MMA
#undef PG8_WAIT_V
#undef PG8_WAIT_L
#undef PG8_BAR
#undef PG8_SCHED
}
}

using namespace pg8;
#define DI __device__ __forceinline__
DI int lnd_tid() { int t = threadIdx.x; asm volatile("" : "+v"(t)); return t; }
DI int lnd_bid() { int t = blockIdx.x; asm volatile("" : "+s"(t)); return t; }
typedef float f32x16 __attribute__((ext_vector_type(16)));
typedef unsigned u32x2 __attribute__((ext_vector_type(2)));
typedef float f32x2 __attribute__((ext_vector_type(2)));

constexpr int D_ = 2048, B_ = 16, S_ = 2048, MT = B_ * S_;
constexpr int DFF = 8192, PLE = 256, NG = 128, NP = 64;
constexpr int MCH = 8192;
constexpr int LDS_GEMM = 131072;
constexpr int LDS_TOTAL = LDS_GEMM + 16;

constexpr size_t W_IN0 = 0;
constexpr size_t W_GLU0 = W_IN0 + 2ull * 2048 * 2048;
constexpr size_t W_QKV0 = W_GLU0 + 2ull * 4096 * 2048;
constexpr size_t W_Q1 = W_QKV0 + 3072ull * 2048;
constexpr size_t W_O0 = W_Q1 + 2048ull * 2048;
constexpr size_t W_10 = W_O0 + 2ull * 2048 * 2048;
constexpr size_t W_20 = W_10 + 4ull * 8192 * 2048;
constexpr size_t W_PLE0 = W_20 + 4ull * 8192 * 2048;
constexpr size_t W_GATE0 = W_PLE0 + 4ull * 2048 * 256;
constexpr size_t W_TOTAL = W_GATE0 + 4ull * 2048 * 2048;

constexpr size_t OFF_BAR = 0;
constexpr size_t OFF_WB = 65536;
constexpr size_t OFF_XN = OFF_WB + W_TOTAL * 2;
constexpr size_t OFF_BIG = OFF_XN + (size_t)MT * D_ * 2;
constexpr size_t OFF_T32 = OFF_BIG + (size_t)MT * D_ * 4;
constexpr size_t OFF_KB = OFF_T32 + (size_t)MT * D_ * 2;
constexpr size_t OFF_VT = OFF_KB + (size_t)MT * 512 * 2;
constexpr size_t OFF_PB = OFF_VT + (size_t)MT * 512 * 2;
constexpr size_t WS_NEED = OFF_PB + (size_t)MT * PLE * 2;

struct Params {
    const float* x; const float* p; const float* a_norm_pre; const float* a_norm_post; const float* ssm_w_in; const float* ssm_a_re; const float* ssm_a_im;
    const float* ssm_log_step; const float* ssm_b_re; const float* ssm_b_im; const float* ssm_c_re; const float* ssm_c_im; const float* ssm_d; const float* ssm_w_glu;
    const float* kv_norm; const float* w_k; const float* w_v; const float* b_norm_pre; const float* b_norm_post; const float* w_q; const float* w_o;
    const float* mlp_norm_pre; const float* mlp_norm_post; const float* mlp_w1; const float* mlp_w2; const float* ple_w; const float* ple_gate;
    float* h; unsigned* bar; bf16_t* wb; bf16_t* xn; bf16_t* big; bf16_t* t32; bf16_t* kb; bf16_t* vt; bf16_t* pb;
};

DI bf16_t f2bf(float f) { unsigned u = __float_as_uint(f); u += 0x7FFFu + ((u >> 16) & 1u); return (bf16_t)(u >> 16); }
DI float bf2f(bf16_t b) { return __uint_as_float(((unsigned)b) << 16); }
DI float shx(float v, int lane, int m) { return __builtin_bit_cast(float, __builtin_amdgcn_ds_bpermute((lane ^ m) << 2, __builtin_bit_cast(int, v))); }
DI float wave_sum(float v, int lane) {
#pragma unroll
    for (int o = 32; o >= 1; o >>= 1) v += shx(v, lane, o);
    return v;
}
DI float sigmoidf_(float x) { return 1.0f / (1.0f + __expf(-x)); }

struct EpiF32s {
    static constexpr bool PERM = false, AFTER_DRAIN = false;
    float* C; int ldc;
    DI void operator()(const f32x4 (&acc)[2][2][4][2], const Unit& u, int wr, int wc, int fr, int fq) const {
        const int row0 = u.pm * BM + wr * 64 + fr, col0 = u.pn * BM + wc * 32 + 4 * fq;
#pragma unroll
        for (int ai = 0; ai < 2; ++ai)
#pragma unroll
            for (int m = 0; m < 4; ++m) { float* rowp = C + (size_t)(row0 + ai * HALF + m * 16) * ldc + col0;
#pragma unroll
                for (int bj = 0; bj < 2; ++bj)
#pragma unroll
                    for (int n = 0; n < 2; ++n) *(f32x4*)(rowp + bj * HALF + n * 16) = acc[ai][bj][m][n]; }
    }
};
struct EpiGlu {
    static constexpr bool PERM = true, AFTER_DRAIN = false;
    bf16_t* C;
    DI void operator()(const f32x4 (&acc)[2][2][4][2], const Unit& u, int wr, int wc, int fr, int fq) const {
        const int row0 = u.pm * BM + wr * 64 + fr, col0 = u.pn * HALF + wc * 32 + 8 * fq;
#pragma unroll
        for (int ai = 0; ai < 2; ++ai)
#pragma unroll
            for (int m = 0; m < 4; ++m) { bf16_t* rowp = C + (size_t)(row0 + ai * HALF + m * 16) * D_ + col0; float o[8];
#pragma unroll
                for (int n = 0; n < 2; ++n) { const f32x4 v = acc[ai][0][m][n], g = acc[ai][1][m][n];
#pragma unroll
                    for (int j = 0; j < 4; ++j) o[n * 4 + j] = v[j] * sigmoidf_(g[j]); }
                u32x4 w; w.x = cvt_pk_bf16(o[0], o[1]); w.y = cvt_pk_bf16(o[2], o[3]); w.z = cvt_pk_bf16(o[4], o[5]); w.w = cvt_pk_bf16(o[6], o[7]);
                *(u32x4*)rowp = w; }
    }
};
struct EpiPle {
    static constexpr bool PERM = false, AFTER_DRAIN = false;
    float* H; const bf16_t* G;
    DI void operator()(const f32x4 (&acc)[2][2][4][2], const Unit& u, int wr, int wc, int fr, int fq) const {
        const int row0 = u.pm * BM + wr * 64 + fr, col0 = u.pn * BM + wc * 32 + 4 * fq;
#pragma unroll
        for (int ai = 0; ai < 2; ++ai)
#pragma unroll
            for (int m = 0; m < 4; ++m) { const size_t ro = (size_t)(row0 + ai * HALF + m * 16) * D_ + col0;
#pragma unroll
                for (int bj = 0; bj < 2; ++bj)
#pragma unroll
                    for (int n = 0; n < 2; ++n) { const size_t o = ro + bj * HALF + n * 16; const u32x2 gq = *(const u32x2*)(G + o); const float g[4] = {__uint_as_float(gq.x << 16), __uint_as_float(gq.x & 0xffff0000u), __uint_as_float(gq.y << 16), __uint_as_float(gq.y & 0xffff0000u)}; f32x4 hv = *(const f32x4*)(H + o); const f32x4 a = acc[ai][bj][m][n];
#pragma unroll
                        for (int j = 0; j < 4; ++j) hv[j] += a[j] * sigmoidf_(g[j]);
                        *(f32x4*)(H + o) = hv; } }
    }
};
template <int ACT  > struct EpiB16 {
    static constexpr bool PERM = true, AFTER_DRAIN = false;
    bf16_t* O; int ldc;
    DI void operator()(const f32x4 (&acc)[2][2][4][2], const Unit& u, int wr, int wc, int fr, int fq) const {
        const int row0 = u.pm * BM + wr * 64 + fr, col0 = u.pn * BM + wc * 32 + 8 * fq;
#pragma unroll
        for (int ai = 0; ai < 2; ++ai)
#pragma unroll
            for (int m = 0; m < 4; ++m) { bf16_t* rowp = O + (size_t)(row0 + ai * HALF + m * 16) * ldc + col0;
#pragma unroll
                for (int bj = 0; bj < 2; ++bj) { f32x4 v0 = acc[ai][bj][m][0], v1 = acc[ai][bj][m][1];
                    if (ACT == 1) {
#pragma unroll
                        for (int j = 0; j < 4; ++j) { const float a = fmaxf(v0[j], 0.f), b = fmaxf(v1[j], 0.f); v0[j] = a * a; v1[j] = b * b; } }
                    u32x4 w; w.x = cvt_pk_bf16(v0[0], v0[1]); w.y = cvt_pk_bf16(v0[2], v0[3]); w.z = cvt_pk_bf16(v1[0], v1[1]); w.w = cvt_pk_bf16(v1[2], v1[3]);
                    *(u32x4*)(rowp + bj * HALF) = w; } }
    }
};
struct EpiQKV {
    static constexpr bool PERM = true, AFTER_DRAIN = false;
    bf16_t* Qb; bf16_t* Kb; bf16_t* Vt; float qscale;
    DI void operator()(const f32x4 (&acc)[2][2][4][2], const Unit& u, int wr, int wc, int fr, int fq) const {
        const int row0 = u.pm * BM + wr * 64 + fr;
        if (u.pn < 10) {
            const bool isq = u.pn < 8; const float sc = isq ? qscale : 1.0f; const int ldc = isq ? 2048 : 512;
            bf16_t* base = isq ? Qb : Kb; const int col0 = (isq ? u.pn : u.pn - 8) * BM + wc * 32 + 8 * fq;
#pragma unroll
            for (int ai = 0; ai < 2; ++ai)
#pragma unroll
                for (int m = 0; m < 4; ++m) { bf16_t* rowp = base + (size_t)(row0 + ai * HALF + m * 16) * ldc + col0;
#pragma unroll
                    for (int bj = 0; bj < 2; ++bj) { const f32x4 v0 = acc[ai][bj][m][0] * sc, v1 = acc[ai][bj][m][1] * sc;
                        u32x4 w; w.x = cvt_pk_bf16(v0[0], v0[1]); w.y = cvt_pk_bf16(v0[2], v0[3]); w.z = cvt_pk_bf16(v1[0], v1[1]); w.w = cvt_pk_bf16(v1[2], v1[3]);
                        *(u32x4*)(rowp + bj * HALF) = w; } }
        } else {
            const int col0 = (u.pn - 10) * BM + wc * 32 + 8 * fq;
#pragma unroll
            for (int ai = 0; ai < 2; ++ai)
#pragma unroll
                for (int m = 0; m < 4; ++m) { const int row = row0 + ai * HALF + m * 16; const int b = row >> 11, s = row & 2047;
#pragma unroll
                    for (int bj = 0; bj < 2; ++bj)
#pragma unroll
                        for (int n = 0; n < 2; ++n)
#pragma unroll
                            for (int j = 0; j < 4; ++j) { const int c = col0 + bj * HALF + 4 * n + j; Vt[((size_t)b * 512 + c) * S_ + s] = f2bf(acc[ai][bj][m][n][j]); } }
        }
    }
};

DI void conv_t(const float* __restrict__ src, int ldsrc, int col0, int K, int N, const float* __restrict__ gain, bf16_t* __restrict__ dst, bool glu) {
    const size_t total = (size_t)N * (K / 8), stride = (size_t)gridDim.x * 512;
    for (size_t idx = (size_t)lnd_bid() * 512 + lnd_tid(); idx < total; idx += stride) {
        const int n_lo = (int)(idx & 15), kq = (int)((idx >> 4) & 3); const size_t rest = idx >> 6; const int nb16 = N >> 4;
        const int n = (int)(rest % (size_t)nb16) * 16 + n_lo, k0 = ((int)(rest / (size_t)nb16) * 4 + kq) * 8;
        int sc = n; if (glu) { const int pn = n >> 8, bj = (n >> 7) & 1, jj = n & 127; sc = bj * 2048 + pn * 128 + jj; }
        const float* s = src + (size_t)k0 * ldsrc + col0 + sc;
        float v[8];
#pragma unroll
        for (int j = 0; j < 8; ++j) v[j] = s[(size_t)j * ldsrc];
        if (gain) {
#pragma unroll
            for (int j = 0; j < 8; ++j) v[j] *= gain[k0 + j]; }
        u32x4 w; w.x = cvt_pk_bf16(v[0], v[1]); w.y = cvt_pk_bf16(v[2], v[3]); w.z = cvt_pk_bf16(v[4], v[5]); w.w = cvt_pk_bf16(v[6], v[7]);
        *(u32x4*)(dst + (size_t)n * K + k0) = w;
    }
}

template <int MODE> DI void row_phase(const float* __restrict__ x, float* __restrict__ h, const bf16_t* __restrict__ t32, const float* __restrict__ gain, bf16_t* __restrict__ xn) {
    const int tid = lnd_tid(); const int wid = tid >> 6, lane = tid & 63;
    for (int row = lnd_bid() * 8 + wid; row < MT; row += gridDim.x * 8) {
        const size_t ro = (size_t)row * D_;
        f32x4 hv[8];
        if (MODE == 0) {
#pragma unroll
            for (int it = 0; it < 8; ++it) hv[it] = *(const f32x4*)(x + ro + it * 256 + lane * 4);
        } else {
#pragma unroll
            for (int it = 0; it < 8; ++it) hv[it] = __builtin_nontemporal_load((const f32x4*)(h + ro + it * 256 + lane * 4));
        }
        if (MODE == 1 || MODE == 2) {
            f32x4 tv[8]; float ss = 0.f;
#pragma unroll
            for (int it = 0; it < 8; ++it) { { const u32x2 tq = __builtin_nontemporal_load((const u32x2*)(t32 + ro + it * 256 + lane * 4)); tv[it] = (f32x4){__uint_as_float(tq.x << 16), __uint_as_float(tq.x & 0xffff0000u), __uint_as_float(tq.y << 16), __uint_as_float(tq.y & 0xffff0000u)}; } ss += tv[it][0] * tv[it][0] + tv[it][1] * tv[it][1] + tv[it][2] * tv[it][2] + tv[it][3] * tv[it][3]; }
            ss = wave_sum(ss, lane); const float r1 = rsqrtf(ss * (1.0f / D_) + 1e-6f);
#pragma unroll
            for (int it = 0; it < 8; ++it) { const f32x4 g = *(const f32x4*)(gain + it * 256 + lane * 4);
#pragma unroll
                for (int j = 0; j < 4; ++j) hv[it][j] += tv[it][j] * r1 * g[j]; }
        }
        if (MODE != 3) {
#pragma unroll
            for (int it = 0; it < 8; ++it) __builtin_nontemporal_store(hv[it], (f32x4*)(h + ro + it * 256 + lane * 4));
        }
        float r2 = 1.0f;
        if (MODE != 2) { float ss = 0.f;
#pragma unroll
            for (int it = 0; it < 8; ++it) ss += hv[it][0] * hv[it][0] + hv[it][1] * hv[it][1] + hv[it][2] * hv[it][2] + hv[it][3] * hv[it][3];
            ss = wave_sum(ss, lane); r2 = rsqrtf(ss * (1.0f / D_) + 1e-6f); }
#pragma unroll
        for (int it = 0; it < 8; ++it) { u32x2 w; w.x = cvt_pk_bf16(hv[it][0] * r2, hv[it][1] * r2); w.y = cvt_pk_bf16(hv[it][2] * r2, hv[it][3] * r2);
            *(u32x2*)(xn + ro + it * 256 + lane * 4) = w; }
    }
}
DI void conv_p(const float* __restrict__ src, bf16_t* __restrict__ dst) {
    const size_t total = (size_t)MT * PLE / 4, stride = (size_t)gridDim.x * 512;
    for (size_t i = (size_t)lnd_bid() * 512 + lnd_tid(); i < total; i += stride) { const f32x4 v = *(const f32x4*)(src + i * 4); u32x2 w; w.x = cvt_pk_bf16(v[0], v[1]); w.y = cvt_pk_bf16(v[2], v[3]); *(u32x2*)(dst + i * 4) = w; }
}

DI void sincos_pi(float r, float& s, float& c) {
    const float y = r * 0.25f, y2 = y * y;
    float sp = y * (1.0f + y2 * (-1.6666667e-1f + y2 * (8.3333333e-3f + y2 * (-1.9841270e-4f + y2 * 2.7557319e-6f))));
    float cp = 1.0f + y2 * (-0.5f + y2 * (4.1666667e-2f + y2 * (-1.3888889e-3f + y2 * (2.4801587e-5f + y2 * -2.7557319e-7f))));
    const float s2 = 2.f * sp * cp, c2 = 1.f - 2.f * sp * sp;
    s = 2.f * s2 * c2; c = 1.f - 2.f * s2 * s2;
}
typedef short s16x4 __attribute__((ext_vector_type(4)));
DI void scan_phase(PG8_LAS unsigned char* lds, const float* a_re_, const float* a_im_, const float* log_step_, const float* b_re_, const float* b_im_, const float* c_re_, const float* c_im_, const float* d_, int j, const bf16_t* __restrict__ U, bf16_t* __restrict__ Y) {
    const int tid = lnd_tid(); const int wid = tid >> 6, lane = tid & 63, l15 = lane & 15, lq = lane >> 4;
    PG8_LAS unsigned char* xl = lds + wid * (16 * 272);
    for (int item = lnd_bid() * 8 + wid; item < B_ * NG; item += gridDim.x * 8) {
        const int b = item / NG, g = item % NG;
        const float dt = expf(log_step_[j * NG + g]);
        float l1r[4], l1i[4], l2r[4], l2i[4], l3r[4], l3i[4], l4r[4], l4i[4];
        s16x4 bfr[8];
#pragma unroll
        for (int a = 0; a < 4; ++a) {
            const int p = 16 * a + l15;
            const float ar = a_re_[((size_t)j * NG + g) * NP + p], ai = a_im_[((size_t)j * NG + g) * NP + p];
            const float mag = expf(ar * dt);
            const float ang = ai * dt;
            const float kk = rintf(ang * 0.15915494309189535f);
            float rr = fmaf(-kk, 6.28125f, ang); rr = fmaf(-kk, 0.0019353071795864769f, rr);
            float sn, cs; sincos_pi(rr, sn, cs);
            const float lbr = mag * cs, lbi = mag * sn;
            const float den = ar * ar + ai * ai, nr = lbr - 1.0f;
            const float fr = (nr * ar + lbi * ai) / den, fi = (lbi * ar - nr * ai) / den;
            float vr[4], vi[4];
#pragma unroll
            for (int jj = 0; jj < 4; ++jj) { const size_t bi_ = (((size_t)j * NG + g) * NP + p) * 16 + 4 * lq + jj; const float br = b_re_[bi_], bi = b_im_[bi_];
                vr[jj] = fr * br - fi * bi; vi[jj] = fr * bi + fi * br; }
            u32x2 wr_, wi_; wr_.x = cvt_pk_bf16(vr[0], vr[1]); wr_.y = cvt_pk_bf16(vr[2], vr[3]); wi_.x = cvt_pk_bf16(vi[0], vi[1]); wi_.y = cvt_pk_bf16(vi[2], vi[3]);
            bfr[a] = __builtin_bit_cast(s16x4, wr_); bfr[4 + a] = __builtin_bit_cast(s16x4, wi_);
            l1r[a] = lbr; l1i[a] = lbi;
            l2r[a] = lbr * lbr - lbi * lbi; l2i[a] = 2.f * lbr * lbi;
            l3r[a] = l2r[a] * lbr - l2i[a] * lbi; l3i[a] = l2r[a] * lbi + l2i[a] * lbr;
            l4r[a] = l2r[a] * l2r[a] - l2i[a] * l2i[a]; l4i[a] = 2.f * l2r[a] * l2i[a];
        }
        bf16x8 cm[4];
#pragma unroll
        for (int ks = 0; ks < 4; ++ks) { u32x4 w;
#pragma unroll
            for (int pr = 0; pr < 4; ++pr) { const int pp = 16 * ks + 4 * lq + pr; const size_t ci = (((size_t)j * NG + g) * 16 + l15) * NP + pp;
                w[pr] = cvt_pk_bf16(c_re_[ci], -c_im_[ci]); }
            cm[ks] = __builtin_bit_cast(bf16x8, w); }
        const float dsk = d_[j * D_ + g * 16 + l15];
        const size_t base = (size_t)b * S_ * D_ + g * 16 + l15 + (size_t)(4 * lq) * D_;
        const size_t abase = (size_t)b * S_ * D_ + (size_t)l15 * D_ + g * 16 + 4 * lq;
        float cr[4] = {0.f, 0.f, 0.f, 0.f}, ci[4] = {0.f, 0.f, 0.f, 0.f};
        float un[4]; u32x2 an;
#pragma unroll
        for (int q = 0; q < 4; ++q) un[q] = bf2f(U[base + (size_t)q * D_]);
        an = *(const u32x2*)(U + abase);
        for (int t0 = 0; t0 < S_; t0 += 16) {
            float uv[4]; const s16x4 au = __builtin_bit_cast(s16x4, an);
#pragma unroll
            for (int q = 0; q < 4; ++q) uv[q] = un[q];
            if (t0 + 16 < S_) {
#pragma unroll
                for (int q = 0; q < 4; ++q) un[q] = bf2f(U[base + (size_t)(t0 + 16 + q) * D_]);
                an = *(const u32x2*)(U + abase + (size_t)(t0 + 16) * D_); }
#pragma unroll
            for (int a = 0; a < 4; ++a) {
                const f32x4 z4 = (f32x4){0.f, 0.f, 0.f, 0.f};
                const f32x4 bur = __builtin_amdgcn_mfma_f32_16x16x16bf16_1k(au, bfr[a], z4, 0, 0, 0), bui = __builtin_amdgcn_mfma_f32_16x16x16bf16_1k(au, bfr[4 + a], z4, 0, 0, 0);
                float xr[4], xi[4];
                xr[0] = bur[0]; xi[0] = bui[0];
#pragma unroll
                for (int i = 1; i < 4; ++i) { xr[i] = l1r[a] * xr[i - 1] - l1i[a] * xi[i - 1] + bur[i]; xi[i] = l1r[a] * xi[i - 1] + l1i[a] * xr[i - 1] + bui[i]; }
                float c_r = cr[a], c_i = ci[a], mr = c_r, mi = c_i;
#pragma unroll
                for (int q = 0; q < 4; ++q) {
                    const float er = __builtin_bit_cast(float, __builtin_amdgcn_ds_bpermute((16 * q + l15) << 2, __builtin_bit_cast(int, xr[3])));
                    const float ei = __builtin_bit_cast(float, __builtin_amdgcn_ds_bpermute((16 * q + l15) << 2, __builtin_bit_cast(int, xi[3])));
                    if (lq == q) { mr = c_r; mi = c_i; }
                    const float nr_ = l4r[a] * c_r - l4i[a] * c_i + er, ni_ = l4r[a] * c_i + l4i[a] * c_r + ei;
                    c_r = nr_; c_i = ni_;
                }
                cr[a] = c_r; ci[a] = c_i;
                const float pr_[4] = {l1r[a], l2r[a], l3r[a], l4r[a]}, pi_[4] = {l1i[a], l2i[a], l3i[a], l4i[a]};
#pragma unroll
                for (int i = 0; i < 4; ++i) {
                    const float fxr = xr[i] + pr_[i] * mr - pi_[i] * mi, fxi = xi[i] + pr_[i] * mi + pi_[i] * mr;
                    *(PG8_LAS unsigned*)(xl + (4 * lq + i) * 272 + (16 * a + l15) * 4) = cvt_pk_bf16(fxr, fxi);
                }
            }
            f32x4 acc = (f32x4){0.f, 0.f, 0.f, 0.f};
#pragma unroll
            for (int ks = 0; ks < 4; ++ks) { const bf16x8 af = *(const PG8_LAS bf16x8*)(xl + l15 * 272 + ks * 64 + lq * 16); acc = __builtin_amdgcn_mfma_f32_16x16x32_bf16(af, cm[ks], acc, 0, 0, 0); }
#pragma unroll
            for (int i = 0; i < 4; ++i) {
                const float yv = acc[i] + dsk * uv[i];
                const float a2 = 1.5957691216057308f * (yv + 0.044715f * yv * yv * yv);
                const float gl = yv / (1.0f + __expf(-a2));
                Y[base + (size_t)(t0 + i) * D_] = f2bf(gl);
            }
        }
    }
}

constexpr int KROW = 272, VROW = 80, KBUF = 32 * KROW, VBUF = 128 * VROW;
DI void attn_phase(PG8_LAS unsigned char* lds, const bf16_t* __restrict__ Q, const bf16_t* __restrict__ Kb, const bf16_t* __restrict__ Vt, bf16_t* __restrict__ O) {
    const int tid = lnd_tid(), bid = lnd_bid(), wid = tid >> 6, lane = tid & 63, r = lane & 31, hh = lane >> 5, hql = wid & 3, wh = wid >> 2;
    PG8_LAS unsigned char* kbuf = lds; PG8_LAS unsigned char* vbuf = lds + 2 * KBUF;
    for (int pi = 0; pi < 4; ++pi) {
        const int PP = bid * 4 + pi; if (PP >= B_ * 4 * 16) break;
        const int pq = PP & 15, hk = (PP >> 4) & 3, b = PP >> 6;
        for (int hf = 0; hf < 2; ++hf) {
            const int qb = hf ? 31 - pq : pq, q0 = qb * 64;
            const int t = q0 + 32 * wh + r; const size_t token = (size_t)b * S_ + t; const int hq = hk * 4 + hql;
            bf16x8 qf[8];
#pragma unroll
            for (int st = 0; st < 8; ++st) qf[st] = *(const bf16x8*)(Q + token * D_ + hq * 128 + st * 16 + hh * 8);
            f32x16 oacc[4];
#pragma unroll
            for (int mt = 0; mt < 4; ++mt)
#pragma unroll
                for (int i = 0; i < 16; ++i) oacc[mt][i] = 0.f;
            float carry = 1.0f;
            const int ntiles = 2 * qb + 2, mydiag = 2 * qb + wh;
            const bf16_t* gK = Kb + ((size_t)b * S_ + (tid >> 4)) * 512 + hk * 128 + (tid & 15) * 8;
            const bf16_t* gV = Vt + ((size_t)(b * 4 + hk) * 128 + (tid >> 2)) * S_ + (tid & 3) * 8;
            const int kw = (tid >> 4) * KROW + (tid & 15) * 16, vw = (tid >> 2) * VROW + (tid & 3) * 8;
            u32x4 rk = *(const u32x4*)(gK + (size_t)(ntiles - 1) * 32 * 512), rv = *(const u32x4*)(gV + (ntiles - 1) * 32);
            *(PG8_LAS u32x4*)(kbuf + kw) = rk;
            *(PG8_LAS u32x2*)(vbuf + vw) = (u32x2){rv.x, rv.y}; *(PG8_LAS u32x2*)(vbuf + vw + 32) = (u32x2){rv.z, rv.w};
            __syncthreads();
            for (int it = 0; it < ntiles; ++it) {
                const int kt = ntiles - 1 - it, cur = it & 1; const bool more = it + 1 < ntiles;
                if (more) { rk = *(const u32x4*)(gK + (size_t)(kt - 1) * 32 * 512); rv = *(const u32x4*)(gV + (kt - 1) * 32); }
                if (kt <= mydiag) {
                    f32x16 sacc;
#pragma unroll
                    for (int i = 0; i < 16; ++i) sacc[i] = 0.f;
                    PG8_LAS unsigned char* kp = kbuf + cur * KBUF + r * KROW + hh * 16;
                    __builtin_amdgcn_s_setprio(1);
#pragma unroll
                    for (int st = 0; st < 8; ++st) { const bf16x8 kf = *(const PG8_LAS bf16x8*)(kp + st * 32); sacc = __builtin_amdgcn_mfma_f32_32x32x16_bf16(kf, qf[st], sacc, 0, 0, 0); }
                    __builtin_amdgcn_s_setprio(0);
                    const bool diag = (kt == mydiag);
                    float kq[16], w[16];
#pragma unroll
                    for (int i = 0; i < 16; ++i) {
                        const int cw = (i & 3) + 8 * (i >> 2) + 4 * hh; const bool valid = !diag || (cw < r);
                        const float E = __builtin_amdgcn_exp2f(fminf(sacc[i], 80.f)); const float rkp = __builtin_amdgcn_rcpf(1.0f + E);
                        kq[i] = valid ? rkp : 1.0f; w[i] = valid ? E * rkp : 0.f;
                    }
                    float gs[4], pg[4];
#pragma unroll
                    for (int g = 0; g < 4; ++g) { gs[g] = (kq[4 * g] * kq[4 * g + 1]) * (kq[4 * g + 2] * kq[4 * g + 3]); pg[g] = shx(gs[g], lane, 32); }
                    float T[4]; T[3] = 1.0f; T[2] = gs[3] * pg[3]; T[1] = T[2] * (gs[2] * pg[2]); T[0] = T[1] * (gs[1] * pg[1]);
                    const float total = T[0] * (gs[0] * pg[0]);
#pragma unroll
                    for (int g = 0; g < 4; ++g) { float run = carry * T[g] * (hh == 0 ? pg[g] : 1.0f);
#pragma unroll
                        for (int jj = 3; jj >= 0; --jj) { const int i = 4 * g + jj; w[i] *= run; run *= kq[i]; } }
                    carry *= total;
                    u32x4 p0, p1;
                    p0.x = cvt_pk_bf16(w[0], w[1]); p0.y = cvt_pk_bf16(w[2], w[3]); p0.z = cvt_pk_bf16(w[4], w[5]); p0.w = cvt_pk_bf16(w[6], w[7]);
                    p1.x = cvt_pk_bf16(w[8], w[9]); p1.y = cvt_pk_bf16(w[10], w[11]); p1.z = cvt_pk_bf16(w[12], w[13]); p1.w = cvt_pk_bf16(w[14], w[15]);
                    const bf16x8 pb0 = __builtin_bit_cast(bf16x8, p0), pb1 = __builtin_bit_cast(bf16x8, p1);
                    PG8_LAS unsigned char* vp = vbuf + cur * VBUF + r * VROW + hh * 32;
                    __builtin_amdgcn_s_setprio(1);
#pragma unroll
                    for (int mt = 0; mt < 4; ++mt) {
                        const bf16x8 va = *(const PG8_LAS bf16x8*)(vp + mt * 32 * VROW), vb = *(const PG8_LAS bf16x8*)(vp + mt * 32 * VROW + 16);
                        oacc[mt] = __builtin_amdgcn_mfma_f32_32x32x16_bf16(va, pb0, oacc[mt], 0, 0, 0);
                        oacc[mt] = __builtin_amdgcn_mfma_f32_32x32x16_bf16(vb, pb1, oacc[mt], 0, 0, 0);
                    }
                    __builtin_amdgcn_s_setprio(0);
                }
                if (more) {
                    *(PG8_LAS u32x4*)(kbuf + (cur ^ 1) * KBUF + kw) = rk;
                    *(PG8_LAS u32x2*)(vbuf + (cur ^ 1) * VBUF + vw) = (u32x2){rv.x, rv.y}; *(PG8_LAS u32x2*)(vbuf + (cur ^ 1) * VBUF + vw + 32) = (u32x2){rv.z, rv.w};
                }
                __syncthreads();
            }
            bf16_t* op = O + token * D_ + hq * 128 + 4 * hh;
#pragma unroll
            for (int mt = 0; mt < 4; ++mt)
#pragma unroll
                for (int g = 0; g < 4; ++g) { u32x2 w2; w2.x = cvt_pk_bf16(oacc[mt][4 * g], oacc[mt][4 * g + 1]); w2.y = cvt_pk_bf16(oacc[mt][4 * g + 2], oacc[mt][4 * g + 3]);
                    *(u32x2*)(op + mt * 32 + g * 8) = w2; }
        }
    }
}

#define GRID_SYNC() do { XcdBarrier b2_ = bar; asm volatile("" : "+s"(b2_.bar)); xcd_barrier(b2_); } while (0)
#ifndef NO_GEMM
#define GEMMCALL gemm_phase(lds, g, S, E, nullptr);
#else
#define GEMMCALL E(*(const f32x4 (*)[2][2][4][2])nullptr, Unit{0,0},0,0,0,0);
#endif
__global__ void __launch_bounds__(512, 2) mega(Params P_unused) {
#define P (*(const __attribute__((address_space(4))) Params*)__builtin_amdgcn_kernarg_segment_ptr())
    extern __shared__ __attribute__((aligned(16))) unsigned char shm[];
    PG8_LAS unsigned char* lds = (PG8_LAS unsigned char*)shm;
    volatile LAS unsigned* xbw = (volatile LAS unsigned*)(lds + LDS_GEMM);
    if (threadIdx.x == 0) { xbw[0] = 0u; xbw[1] = 0u; xbw[2] = 0u; xbw[3] = 0u; }
    __syncthreads();
    XcdBarrier bar = xcd_barrier_post(P.bar, xbw);
    const int G = gridDim.x, c = blockIdx.x;
    const float qscale = 0.08838834764831845f * 1.4426950408889634f;

#ifdef PROBE_PRO
#pragma unroll 1
    for (int rep_ = 0; rep_ < 2; ++rep_)
#endif
#pragma unroll 1
    for (int w = 0; w < 26; ++w) {
        const float* src; const float* gain = nullptr; bf16_t* dst; int ldsrc = D_, K = D_, N = D_; bool glu = false;
        if (w < 2)       { src = P.ssm_w_in + (size_t)w * D_ * D_; gain = P.a_norm_pre + w * D_; dst = P.wb + W_IN0 + (size_t)w * D_ * D_; }
        else if (w < 4)  { const int j = w - 2; src = P.ssm_w_glu + (size_t)j * D_ * 2 * D_; ldsrc = 2 * D_; N = 2 * D_; dst = P.wb + W_GLU0 + (size_t)j * 2 * D_ * D_; glu = true; }
        else if (w < 6)  { const int j = w - 4; src = P.w_o + (size_t)j * D_ * D_; dst = P.wb + W_O0 + (size_t)j * D_ * D_; }
        else if (w == 6) { src = P.w_q; gain = P.b_norm_pre; dst = P.wb + W_QKV0; }
        else if (w == 7) { src = P.w_k; ldsrc = 512; N = 512; gain = P.kv_norm; dst = P.wb + W_QKV0 + 2048ull * D_; }
        else if (w == 8) { src = P.w_v; ldsrc = 512; N = 512; gain = P.kv_norm; dst = P.wb + W_QKV0 + 2560ull * D_; }
        else if (w == 9) { src = P.w_q + (size_t)D_ * D_; gain = P.b_norm_pre + D_; dst = P.wb + W_Q1; }
        else if (w < 14) { const int i = w - 10; src = P.mlp_w1 + (size_t)i * D_ * DFF; ldsrc = DFF; N = DFF; gain = P.mlp_norm_pre + i * D_; dst = P.wb + W_10 + (size_t)i * DFF * D_; }
        else if (w < 18) { const int i = w - 14; src = P.mlp_w2 + (size_t)i * DFF * D_; K = DFF; dst = P.wb + W_20 + (size_t)i * DFF * D_; }
        else if (w < 22) { const int i = w - 18; src = P.ple_w + (size_t)i * PLE * D_; K = PLE; dst = P.wb + W_PLE0 + (size_t)i * D_ * PLE; }
        else             { const int i = w - 22; src = P.ple_gate + (size_t)i * D_ * D_; dst = P.wb + W_GATE0 + (size_t)i * D_ * D_; }
        conv_t(src, ldsrc, 0, K, N, gain, dst, glu);
    }
    row_phase<0>(P.x, P.h, nullptr, nullptr, P.xn);
    GRID_SYNC();

#pragma unroll 1
    for (int layer = 0; layer < 4; ++layer) {
        if (layer < 2) {
            const int j = layer;
            { Gemm g{P.xn, P.wb + W_IN0 + (size_t)j * D_ * D_, MT, D_, D_}; StaticOrder S; S.init(g.M, g.N, G, lnd_bid()); EpiB16<0> E{P.big, D_}; GEMMCALL }
            GRID_SYNC();
#ifndef NO_SCAN
            scan_phase(lds, P.ssm_a_re, P.ssm_a_im, P.ssm_log_step, P.ssm_b_re, P.ssm_b_im, P.ssm_c_re, P.ssm_c_im, P.ssm_d, j, P.big, P.xn);
#endif
            GRID_SYNC();
            { Gemm g{P.xn, P.wb + W_GLU0 + (size_t)j * 2 * D_ * D_, MT, 2 * D_, D_}; StaticOrder S; S.init(g.M, g.N, G, lnd_bid()); EpiGlu E{P.t32}; GEMMCALL }
            GRID_SYNC();
            row_phase<1>(nullptr, P.h, P.t32, P.a_norm_post + j * D_, P.xn);
            GRID_SYNC();
        } else {
            const int j = layer - 2;
            if (j == 0) { Gemm g{P.xn, P.wb + W_QKV0, MT, 3072, D_}; StaticOrder S; S.init(g.M, g.N, G, lnd_bid()); EpiQKV E{P.big, P.kb, P.vt, qscale}; GEMMCALL }
            else        { Gemm g{P.xn, P.wb + W_Q1, MT, D_, D_}; StaticOrder S; S.init(g.M, g.N, G, lnd_bid()); EpiQKV E{P.big, P.kb, P.vt, qscale}; GEMMCALL }
            GRID_SYNC();
#ifndef NO_ATTN
            attn_phase(lds, P.big, P.kb, P.vt, P.xn);
#endif
            GRID_SYNC();
            { Gemm g{P.xn, P.wb + W_O0 + (size_t)j * D_ * D_, MT, D_, D_}; StaticOrder S; S.init(g.M, g.N, G, lnd_bid()); EpiB16<0> E{P.t32, D_}; GEMMCALL }
            GRID_SYNC();
            row_phase<1>(nullptr, P.h, P.t32, P.b_norm_post + j * D_, P.xn);
            GRID_SYNC();
        }
#pragma unroll 1
        for (int ch = 0; ch < MT / MCH; ++ch) {
            { Gemm g{P.xn + (size_t)ch * MCH * D_, P.wb + W_10 + (size_t)layer * DFF * D_, MCH, DFF, D_}; StaticOrder S; S.init(g.M, g.N, G, lnd_bid()); EpiB16<1> E{P.big, DFF}; GEMMCALL }
            GRID_SYNC();
            { Gemm g{P.big, P.wb + W_20 + (size_t)layer * DFF * D_, MCH, D_, DFF}; StaticOrder S; S.init(g.M, g.N, G, lnd_bid()); EpiB16<0> E{P.t32 + (size_t)ch * MCH * D_, D_}; GEMMCALL }
            GRID_SYNC();
        }
        row_phase<2>(nullptr, P.h, P.t32, P.mlp_norm_post + layer * D_, P.xn);
        conv_p(P.p + (size_t)layer * MT * PLE, P.pb);
        GRID_SYNC();
        { Gemm g{P.xn, P.wb + W_GATE0 + (size_t)layer * D_ * D_, MT, D_, D_}; StaticOrder S; S.init(g.M, g.N, G, lnd_bid()); EpiB16<0> E{P.t32, D_}; GEMMCALL }
        GRID_SYNC();
        { Gemm g{P.pb, P.wb + W_PLE0 + (size_t)layer * D_ * PLE, MT, D_, PLE}; StaticOrder S; S.init(g.M, g.N, G, lnd_bid()); EpiPle E{P.h, P.t32}; GEMMCALL }
        GRID_SYNC();
        if (layer < 3) { row_phase<3>(nullptr, P.h, nullptr, nullptr, P.xn); GRID_SYNC(); }
#ifdef PROBE_ROW3
        if (layer < 3) { row_phase<3>(nullptr, P.h, nullptr, nullptr, P.xn); GRID_SYNC(); }
#endif
    }
}
#undef P

extern "C" void kernel_launch(void* const* d_in, const int* in_sizes, int n_in, void* d_out, int out_size, void* d_ws, size_t ws_size, hipStream_t stream) {
    (void)in_sizes; (void)n_in; (void)out_size;
    if (ws_size < WS_NEED) { fprintf(stderr, "workspace too small: %zu < %zu\n", ws_size, (size_t)WS_NEED); return; }
    static bool attr_set = false;
    if (!attr_set) { hipFuncSetAttribute((const void*)mega, hipFuncAttributeMaxDynamicSharedMemorySize, LDS_TOTAL); attr_set = true; }
    unsigned char* ws = (unsigned char*)d_ws;
    Params P{};
    const float** f = (const float**)&P;
    for (int i = 0; i < 27; ++i) f[i] = (const float*)d_in[i];
    P.h = (float*)d_out; P.bar = (unsigned*)(ws + OFF_BAR); P.wb = (bf16_t*)(ws + OFF_WB); P.xn = (bf16_t*)(ws + OFF_XN); P.big = (bf16_t*)(ws + OFF_BIG);
    P.t32 = (bf16_t*)(ws + OFF_T32); P.kb = (bf16_t*)(ws + OFF_KB); P.vt = (bf16_t*)(ws + OFF_VT); P.pb = (bf16_t*)(ws + OFF_PB);
    hipMemsetAsync(P.bar, 0, XCD_BAR_WORDS * sizeof(unsigned), stream);
    int dev = 0, cus = 256; hipGetDevice(&dev); hipDeviceGetAttribute(&cus, hipDeviceAttributeMultiprocessorCount, dev);
    hipLaunchKernelGGL(mega, dim3(cus), dim3(512), LDS_TOTAL, stream, P);
}
```

```cpp
#include <hip/hip_runtime.h>
#include <cstdio>
#include <cstdint>
#include <cstdlib>
#include <vector>

#define XB_TMO      128
#define XB_XCNT(j)  (256  + 64 * (j))
#define XB_XSUB(j)  (1280 + 64 * (j))
#define XB_XGEN(j)  (2304 + 64 * (j))
#define XB_TOP      3328
#define XB_TOPGEN   3392
#define XCD_BAR_WORDS 3456
#define XB_SPIN_CAP (1u << 18)
#define LAS __attribute__((address_space(3)))

__device__ __forceinline__ unsigned xb_ld(unsigned* p)              { return __hip_atomic_load(p, __ATOMIC_RELAXED, __HIP_MEMORY_SCOPE_AGENT); }
__device__ __forceinline__ unsigned xb_add(unsigned* p, unsigned v) { return __hip_atomic_fetch_add(p, v, __ATOMIC_RELAXED, __HIP_MEMORY_SCOPE_AGENT); }
__device__ __forceinline__ unsigned xb_xcc_id() { return (unsigned)__builtin_amdgcn_s_getreg((3 << 11) | 20) & 0xFu; }
#define XB_SPIN(cond, bar) do { unsigned _sp = 0; while (cond) { __builtin_amdgcn_s_sleep(1); \
    if ((++_sp & 255u) == 0u) { if (xb_ld(&(bar)[XB_TMO])) break; if (_sp > XB_SPIN_CAP) { atomicAdd(&(bar)[XB_TMO], 1u); break; } } } } while (0)

struct XcdBarrier {
    unsigned* bar; unsigned x;
    volatile LAS unsigned* st;
};

__device__ __forceinline__ XcdBarrier xcd_barrier_post(unsigned* bar, volatile LAS unsigned* st) {
    XcdBarrier b; b.bar = bar; b.x = xb_xcc_id(); b.st = st;
    if (threadIdx.x == 0) (void)xb_add(&bar[XB_XCNT(b.x)], 1u);
    return b;
}
__device__ __forceinline__ void xcd_barrier_complete(unsigned* bar, unsigned x, unsigned& nloc, unsigned& nx) {
    const unsigned G = gridDim.x * gridDim.y * gridDim.z;
    unsigned sum, cnt, mine, sp = 0u;
    for (;;) {
        sum = 0u; cnt = 0u; mine = 0u;
#pragma unroll
        for (unsigned j = 0; j < 16; ++j) { const unsigned c = xb_ld(&bar[XB_XCNT(j)]); sum += c; cnt += (c > 0u) ? 1u : 0u; mine = (j == x) ? c : mine; }
        if (sum == G) break;
        __builtin_amdgcn_s_sleep(1);
        if ((++sp & 255u) == 0u) { if (xb_ld(&bar[XB_TMO])) break; if (sp > XB_SPIN_CAP) { atomicAdd(&bar[XB_TMO], 1u); break; } }
    }
    nloc = mine > 0u ? mine : 1u; nx = cnt > 0u ? cnt : 1u;
}

__device__ __forceinline__ void xcd_barrier(const XcdBarrier& b) {
    asm volatile("s_waitcnt vmcnt(0)" ::: "memory");
    __syncthreads();
    if (threadIdx.x == 0) {
        unsigned* bar = b.bar;
        __builtin_amdgcn_s_waitcnt(0);
        unsigned nloc = b.st[0], nx = b.st[1];
        if (nloc == 0u) { xcd_barrier_complete(bar, b.x, nloc, nx); b.st[0] = nloc; b.st[1] = nx; }
        const unsigned old = xb_add(&bar[XB_XSUB(b.x)], 1u);
        const unsigned gen = old / nloc;
        if (old + 1u == (gen + 1u) * nloc) {
            __builtin_amdgcn_fence(__ATOMIC_RELEASE, "agent");
            asm volatile("s_waitcnt vmcnt(0)" ::: "memory");
            const unsigned og = xb_add(&bar[XB_TOP], 1u);
            const unsigned tg = og / nx;
            if (og + 1u == (tg + 1u) * nx) xb_add(&bar[XB_TOPGEN], 1u);
            else XB_SPIN(xb_ld(&bar[XB_TOPGEN]) == tg, bar);
            __builtin_amdgcn_fence(__ATOMIC_ACQUIRE, "agent");
            xb_add(&bar[XB_XGEN(b.x)], 1u);
            asm volatile("s_waitcnt vmcnt(0)" ::: "memory");
        } else {
            XB_SPIN(xb_ld(&bar[XB_XGEN(b.x)]) == gen, bar);
            __builtin_amdgcn_fence(__ATOMIC_ACQUIRE, "agent");
            asm volatile("s_waitcnt vmcnt(0)" ::: "memory");
        }
    }
    __syncthreads();
}
namespace pg8 {
#define PG8_LAS __attribute__((address_space(3)))
typedef unsigned short bf16_t;
typedef short bf16x8 __attribute__((ext_vector_type(8)));
typedef float f32x4 __attribute__((ext_vector_type(4)));
typedef unsigned u32x4 __attribute__((ext_vector_type(4)));
constexpr int BM = 256, BK = 64, HALF = 128, HTB = HALF * BK * 2  , STAGE_BYTES = 8 * HTB, NXCD = 8, WGM = 8;

__host__ __device__ __forceinline__ int lds_byte(int r, int c) { const int st = (r >> 4) * 2 + (c >> 5), rr = r & 15, cc = c & 31, ob = rr * 64 + cc * 2; return st * 1024 + (ob ^ (((ob >> 9) & 1) << 5)); }
__host__ __device__ __forceinline__ void stage_rc(int b, int& R, int& C) { const int st = b / 1024, sb = b % 1024, swz = sb ^ (((sb >> 9) & 1) << 5); R = (st >> 1) * 16 + swz / 64; C = (st & 1) * 32 + (swz % 64) / 2; }
__host__ __device__ __forceinline__ int perm32(int rho) { const int n = rho >> 4, i = rho & 15; return 8 * (i >> 2) + 4 * n + (i & 3); }

struct Unit { int pm, pn; };
struct Gemm { const bf16_t* A; const bf16_t* Bt; int M, N, K; };
struct StaticOrder {
    int nM, nN, nwg, G, c;
    __host__ __device__ void init(int M, int N, int G_, int c_) { nM = M / BM; nN = N / BM; nwg = nM * nN; G = G_; c = c_; }
    __host__ __device__ bool next(int i, Unit& u) const {
        const int L = i * G + c; if (L >= nwg) return false;
        int wgid = (int)L; { const int q = nwg / NXCD, r = nwg % NXCD, xcd = wgid % NXCD, off = wgid / NXCD; wgid = (xcd < r ? xcd * (q + 1) : r * (q + 1) + (xcd - r) * q) + off; }
        const int nig = WGM * nN, gid = wgid / nig, fm = gid * WGM, gsz = (nM - fm) < WGM ? (nM - fm) : WGM;
        u.pm = fm + ((wgid % nig) % gsz); u.pn = (wgid % nig) / gsz; return true;
    }
    __device__ __forceinline__ void a_ready(const Unit&) const {}
    __device__ __forceinline__ void done(const Unit&) const {}
};
__device__ __forceinline__ unsigned cvt_pk_bf16(float lo, float hi) { unsigned r; asm volatile("v_cvt_pk_bf16_f32 %0, %1, %2" : "=v"(r) : "v"(lo), "v"(hi)); return r; }
template <class Epi, class Sched, bool STAMP = false>
__device__ __forceinline__ void gemm_phase(PG8_LAS unsigned char* lds, const Gemm g, const Sched& S, const Epi& E, unsigned long long* stamps) {
    int tid_l = threadIdx.x; asm volatile("" : "+v"(tid_l));
    const int tid = tid_l, wid = __builtin_amdgcn_readfirstlane(tid >> 6), lane = tid & 63, wr = wid >> 2, wc = wid & 3, fr = lane & 15, fq = lane >> 4;
    const int K = g.K, nt = K / BK;
    int ts_lo = 0, ts_hi = 0, nts = 0; const unsigned long long rt_entry = STAMP ? (unsigned long long)wall_clock64() : 0ull;
#define PG8_STAMP() do { if (STAMP && wid == 0 && nts < 64) { const unsigned long long _c = (unsigned long long)clock64(); \
        ts_lo = (lane == nts) ? (int)(unsigned)_c : ts_lo; ts_hi = (lane == nts) ? (int)(unsigned)(_c >> 32) : ts_hi; ++nts; } } while (0)
    PG8_STAMP();
    unsigned voffA[2], voffB[2];
#pragma unroll
    for (int i = 0; i < 2; ++i) { int R, C; stage_rc(tid * 16 + i * 8192, R, C); const int Rb = Epi::PERM ? ((R & ~31) + perm32(R & 31)) : R;
        voffA[i] = (unsigned)(R * K + C) * 2u; voffB[i] = (unsigned)(Rb * K + C) * 2u; }
    const size_t kstep = (size_t)(BK * 2);
    const size_t hstep = (size_t)HALF * K * 2;
    const size_t tstep = 2 * hstep;
    const unsigned ldsw = (unsigned)wid * 1024u;
    const int aoff = lds_byte(wr * 64 + fr, fq * 8), boff = lds_byte(wc * 32 + fr, fq * 8);
#define PG8_SA(b, h) (((b) * 2 + (h)) * HTB)
#define PG8_SB(b, h) ((4 + (b) * 2 + (h)) * HTB)
#define PG8_STAGE(bufoff, gbase, voff) do { _Pragma("unroll") for (int _i = 0; _i < 2; ++_i) \
        __builtin_amdgcn_global_load_lds((const unsigned*)((const char*)(gbase) + (voff)[_i]), (PG8_LAS unsigned*)(lds + (bufoff) + ldsw + _i * 8192), 16, 0, 0); } while (0)
#define PG8_LDA(dst, b, h) do { _Pragma("unroll") for (int m = 0; m < 4; ++m) _Pragma("unroll") for (int k = 0; k < 2; ++k) dst[m][k] = *(const PG8_LAS bf16x8*)(lds + PG8_SA(b, h) + aoff + m * 2048 + k * 1024); } while (0)
#define PG8_LDB(dst, b, h) do { _Pragma("unroll") for (int n = 0; n < 2; ++n) _Pragma("unroll") for (int k = 0; k < 2; ++k) dst[n][k] = *(const PG8_LAS bf16x8*)(lds + PG8_SB(b, h) + boff + n * 2048 + k * 1024); } while (0)
#define PG8_MMA(ai, bj, At, Bt) do { __builtin_amdgcn_s_setprio(1); _Pragma("unroll") for (int m = 0; m < 4; ++m) _Pragma("unroll") for (int n = 0; n < 2; ++n) _Pragma("unroll") for (int k = 0; k < 2; ++k) \
        acc[ai][bj][m][n] = __builtin_amdgcn_mfma_f32_16x16x32_bf16(Bt[n][k], At[m][k], acc[ai][bj][m][n], 0, 0, 0); __builtin_amdgcn_s_setprio(0); } while (0)
#define PG8_WAIT_V(n) asm volatile("s_waitcnt vmcnt(" #n ")" ::: "memory")
#define PG8_WAIT_L(n) asm volatile("s_waitcnt lgkmcnt(" #n ")" ::: "memory")
#define PG8_BAR __builtin_amdgcn_s_barrier()
#define PG8_SCHED __builtin_amdgcn_sched_barrier(0)
    Unit cur, nxt; int ui = 0;
    if (!S.next(0, cur)) return;
    f32x4 acc[2][2][4][2];
#pragma unroll
    for (int a = 0; a < 2; ++a)
#pragma unroll
        for (int b = 0; b < 2; ++b)
#pragma unroll
            for (int m = 0; m < 4; ++m)
#pragma unroll
                for (int n = 0; n < 2; ++n) acc[a][b][m][n] = (f32x4){0.f, 0.f, 0.f, 0.f};
    bf16x8 At[4][2], B0[2][2], B1[2][2];
    const char* cA = (const char*)g.A + (size_t)cur.pm * tstep; const char* cB = (const char*)g.Bt + (size_t)cur.pn * tstep;
    S.a_ready(cur);
    PG8_STAGE(PG8_SB(0, 0), cB, voffB); PG8_STAGE(PG8_SA(0, 0), cA, voffA); PG8_STAGE(PG8_SB(0, 1), cB + hstep, voffB); PG8_STAGE(PG8_SA(0, 1), cA + hstep, voffA);
    if (wr == 1) PG8_BAR;
    PG8_WAIT_V(4); PG8_BAR;
    PG8_STAGE(PG8_SB(1, 0), cB + kstep, voffB); PG8_STAGE(PG8_SA(1, 0), cA + kstep, voffA); PG8_STAGE(PG8_SB(1, 1), cB + hstep + kstep, voffB);
    PG8_WAIT_V(6); PG8_BAR;
    PG8_STAMP();
    for (;;) {
        const bool has_next = S.next(ui + 1, nxt);
        const char* nA = has_next ? (const char*)g.A + (size_t)nxt.pm * tstep : cA; const char* nB = has_next ? (const char*)g.Bt + (size_t)nxt.pn * tstep : cB;
        for (int t = 0; t < nt; t += 2) {
            const bool last = (t == nt - 2);
            const char* a1 = cA + (size_t)(t + 1) * kstep;
            const char* a2 = last ? nA : cA + (size_t)(t + 2) * kstep; const char* b2 = last ? nB : cB + (size_t)(t + 2) * kstep;
            const char* a3 = a2 + kstep; const char* b3 = b2 + kstep;
            if (last && has_next) S.a_ready(nxt);
            PG8_LDB(B0, 0, 0); PG8_SCHED; PG8_LDA(At, 0, 0); PG8_STAGE(PG8_SA(1, 1), a1 + hstep, voffA);
            PG8_WAIT_L(8); PG8_BAR; PG8_WAIT_L(0); PG8_MMA(0, 0, At, B0); PG8_BAR; PG8_SCHED;
            PG8_LDB(B1, 0, 1); PG8_STAGE(PG8_SB(0, 0), b2, voffB);
            PG8_BAR; PG8_WAIT_L(0); PG8_MMA(0, 1, At, B1); PG8_BAR;
            PG8_LDA(At, 0, 1); PG8_STAGE(PG8_SA(0, 0), a2, voffA);
            PG8_BAR; PG8_WAIT_L(0); PG8_MMA(1, 0, At, B0); PG8_BAR; PG8_SCHED;
            PG8_STAGE(PG8_SB(0, 1), b2 + hstep, voffB);
            PG8_WAIT_V(6); PG8_BAR; PG8_MMA(1, 1, At, B1); PG8_BAR;
            PG8_LDB(B0, 1, 0); PG8_SCHED; PG8_LDA(At, 1, 0); PG8_STAGE(PG8_SA(0, 1), a2 + hstep, voffA);
            PG8_WAIT_L(8); PG8_BAR; PG8_WAIT_L(0); PG8_MMA(0, 0, At, B0); PG8_BAR; PG8_SCHED;
            PG8_LDB(B1, 1, 1); PG8_STAGE(PG8_SB(1, 0), b3, voffB);
            PG8_BAR; PG8_WAIT_L(0); PG8_MMA(0, 1, At, B1); PG8_BAR;
            PG8_LDA(At, 1, 1); PG8_STAGE(PG8_SA(1, 0), a3, voffA);
            PG8_BAR; PG8_WAIT_L(0); PG8_MMA(1, 0, At, B0); PG8_BAR; PG8_SCHED;
            PG8_STAGE(PG8_SB(1, 1), b3 + hstep, voffB);
            PG8_WAIT_V(6); PG8_BAR; PG8_MMA(1, 1, At, B1); PG8_BAR;
        }
        PG8_STAMP();
        if constexpr (!Epi::AFTER_DRAIN) { int l2 = threadIdx.x; asm volatile("" : "+v"(l2)); l2 &= 63; E(acc, cur, wr, wc, l2 & 15, l2 >> 4); S.done(cur); }
        PG8_STAMP();
        if (!has_next) break;
#pragma unroll
        for (int a = 0; a < 2; ++a)
#pragma unroll
            for (int b = 0; b < 2; ++b)
#pragma unroll
                for (int m = 0; m < 4; ++m)
#pragma unroll
                    for (int n = 0; n < 2; ++n) acc[a][b][m][n] = (f32x4){0.f, 0.f, 0.f, 0.f};
        cur = nxt; cA = nA; cB = nB; ++ui;
    }
    PG8_WAIT_V(0);
    if (wr == 0) PG8_BAR;
    PG8_BAR;
    if constexpr (Epi::AFTER_DRAIN) { E.fused(acc, cur, wr, wc, fr, fq, lds, wid, lane); S.done(cur); }
    PG8_STAMP();
    if (STAMP && wid == 0) { stamps[lane] = lane < nts ? (((unsigned long long)(unsigned)ts_hi << 32) | (unsigned)ts_lo) : 0ull;
        if (lane == 62) stamps[62] = rt_entry; if (lane == 63) stamps[63] = (unsigned long long)wall_clock64(); }
#undef PG8_STAMP
#undef PG8_SA
#undef PG8_SB
#undef PG8_STAGE
#undef PG8_LDA
#undef PG8_LDB
#undef PG8_MMA
#undef PG8_WAIT_V
#undef PG8_WAIT_L
#undef PG8_BAR
#undef PG8_SCHED
}
}

using namespace pg8;
#define DI __device__ __forceinline__
DI int lnd_tid() { int t = threadIdx.x; asm volatile("" : "+v"(t)); return t; }
DI int lnd_bid() { int t = blockIdx.x; asm volatile("" : "+s"(t)); return t; }
typedef float f32x16 __attribute__((ext_vector_type(16)));
typedef unsigned u32x2 __attribute__((ext_vector_type(2)));
typedef float f32x2 __attribute__((ext_vector_type(2)));

constexpr int D_ = 2048, B_ = 16, S_ = 2048, MT = B_ * S_;
constexpr int DFF = 8192, PLE = 256, NG = 128, NP = 64;
constexpr int MCH = 8192;
constexpr int LDS_GEMM = 131072;
constexpr int LDS_TOTAL = LDS_GEMM + 16;

constexpr size_t W_IN0 = 0;
constexpr size_t W_GLU0 = W_IN0 + 2ull * 2048 * 2048;
constexpr size_t W_QKV0 = W_GLU0 + 2ull * 4096 * 2048;
constexpr size_t W_Q1 = W_QKV0 + 3072ull * 2048;
constexpr size_t W_O0 = W_Q1 + 2048ull * 2048;
constexpr size_t W_10 = W_O0 + 2ull * 2048 * 2048;
constexpr size_t W_20 = W_10 + 4ull * 8192 * 2048;
constexpr size_t W_PLE0 = W_20 + 4ull * 8192 * 2048;
constexpr size_t W_GATE0 = W_PLE0 + 4ull * 2048 * 256;
constexpr size_t W_TOTAL = W_GATE0 + 4ull * 2048 * 2048;

constexpr size_t OFF_BAR = 0;
constexpr size_t OFF_WB = 65536;
constexpr size_t OFF_XN = OFF_WB + W_TOTAL * 2;
constexpr size_t OFF_BIG = OFF_XN + (size_t)MT * D_ * 2;
constexpr size_t OFF_T32 = OFF_BIG + (size_t)MT * D_ * 4;
constexpr size_t OFF_KB = OFF_T32 + (size_t)MT * D_ * 2;
constexpr size_t OFF_VT = OFF_KB + (size_t)MT * 512 * 2;
constexpr size_t OFF_PB = OFF_VT + (size_t)MT * 512 * 2;
constexpr size_t WS_NEED = OFF_PB + (size_t)MT * PLE * 2;

struct Params {
    const float* x; const float* p; const float* a_norm_pre; const float* a_norm_post; const float* ssm_w_in; const float* ssm_a_re; const float* ssm_a_im;
    const float* ssm_log_step; const float* ssm_b_re; const float* ssm_b_im; const float* ssm_c_re; const float* ssm_c_im; const float* ssm_d; const float* ssm_w_glu;
    const float* kv_norm; const float* w_k; const float* w_v; const float* b_norm_pre; const float* b_norm_post; const float* w_q; const float* w_o;
    const float* mlp_norm_pre; const float* mlp_norm_post; const float* mlp_w1; const float* mlp_w2; const float* ple_w; const float* ple_gate;
    float* h; unsigned* bar; bf16_t* wb; bf16_t* xn; bf16_t* big; bf16_t* t32; bf16_t* kb; bf16_t* vt; bf16_t* pb;
};

DI bf16_t f2bf(float f) { unsigned u = __float_as_uint(f); u += 0x7FFFu + ((u >> 16) & 1u); return (bf16_t)(u >> 16); }
DI float bf2f(bf16_t b) { return __uint_as_float(((unsigned)b) << 16); }
DI float shx(float v, int lane, int m) { return __builtin_bit_cast(float, __builtin_amdgcn_ds_bpermute((lane ^ m) << 2, __builtin_bit_cast(int, v))); }
DI float wave_sum(float v, int lane) {
#pragma unroll
    for (int o = 32; o >= 1; o >>= 1) v += shx(v, lane, o);
    return v;
}
DI float sigmoidf_(float x) { return __builtin_amdgcn_rcpf(1.0f + __expf(-x)); }

struct EpiF32s {
    static constexpr bool PERM = false, AFTER_DRAIN = false;
    float* C; int ldc;
    DI void operator()(const f32x4 (&acc)[2][2][4][2], const Unit& u, int wr, int wc, int fr, int fq) const {
        const int row0 = u.pm * BM + wr * 64 + fr, col0 = u.pn * BM + wc * 32 + 4 * fq;
#pragma unroll
        for (int ai = 0; ai < 2; ++ai)
#pragma unroll
            for (int m = 0; m < 4; ++m) { float* rowp = C + (size_t)(row0 + ai * HALF + m * 16) * ldc + col0;
#pragma unroll
                for (int bj = 0; bj < 2; ++bj)
#pragma unroll
                    for (int n = 0; n < 2; ++n) *(f32x4*)(rowp + bj * HALF + n * 16) = acc[ai][bj][m][n]; }
    }
};
struct EpiGlu {
    static constexpr bool PERM = true, AFTER_DRAIN = false;
    bf16_t* C;
    DI void operator()(const f32x4 (&acc)[2][2][4][2], const Unit& u, int wr, int wc, int fr, int fq) const {
        const int row0 = u.pm * BM + wr * 64 + fr, col0 = u.pn * HALF + wc * 32 + 8 * fq;
#pragma unroll
        for (int ai = 0; ai < 2; ++ai)
#pragma unroll
            for (int m = 0; m < 4; ++m) { bf16_t* rowp = C + (size_t)(row0 + ai * HALF + m * 16) * D_ + col0; float o[8];
#pragma unroll
                for (int n = 0; n < 2; ++n) { const f32x4 v = acc[ai][0][m][n], g = acc[ai][1][m][n];
#pragma unroll
                    for (int j = 0; j < 4; ++j) o[n * 4 + j] = v[j] * sigmoidf_(g[j]); }
                u32x4 w; w.x = cvt_pk_bf16(o[0], o[1]); w.y = cvt_pk_bf16(o[2], o[3]); w.z = cvt_pk_bf16(o[4], o[5]); w.w = cvt_pk_bf16(o[6], o[7]);
                *(u32x4*)rowp = w; }
    }
};
struct EpiPle {
    static constexpr bool PERM = false, AFTER_DRAIN = false;
    float* H; const bf16_t* G;
    DI void operator()(const f32x4 (&acc)[2][2][4][2], const Unit& u, int wr, int wc, int fr, int fq) const {
        const int row0 = u.pm * BM + wr * 64 + fr, col0 = u.pn * BM + wc * 32 + 4 * fq;
#pragma unroll
        for (int ai = 0; ai < 2; ++ai)
#pragma unroll
            for (int m = 0; m < 4; ++m) { const size_t ro = (size_t)(row0 + ai * HALF + m * 16) * D_ + col0;
#pragma unroll
                for (int bj = 0; bj < 2; ++bj)
#pragma unroll
                    for (int n = 0; n < 2; ++n) { const size_t o = ro + bj * HALF + n * 16; const u32x2 gq = *(const u32x2*)(G + o); const float g[4] = {__uint_as_float(gq.x << 16), __uint_as_float(gq.x & 0xffff0000u), __uint_as_float(gq.y << 16), __uint_as_float(gq.y & 0xffff0000u)}; f32x4 hv = *(const f32x4*)(H + o); const f32x4 a = acc[ai][bj][m][n];
#pragma unroll
                        for (int j = 0; j < 4; ++j) hv[j] += a[j] * sigmoidf_(g[j]);
                        *(f32x4*)(H + o) = hv; } }
    }
};
template <int ACT  > struct EpiB16 {
    static constexpr bool PERM = true, AFTER_DRAIN = false;
    bf16_t* O; int ldc;
    DI void operator()(const f32x4 (&acc)[2][2][4][2], const Unit& u, int wr, int wc, int fr, int fq) const {
        const int row0 = u.pm * BM + wr * 64 + fr, col0 = u.pn * BM + wc * 32 + 8 * fq;
#pragma unroll
        for (int ai = 0; ai < 2; ++ai)
#pragma unroll
            for (int m = 0; m < 4; ++m) { bf16_t* rowp = O + (size_t)(row0 + ai * HALF + m * 16) * ldc + col0;
#pragma unroll
                for (int bj = 0; bj < 2; ++bj) { f32x4 v0 = acc[ai][bj][m][0], v1 = acc[ai][bj][m][1];
                    if (ACT == 1) {
#pragma unroll
                        for (int j = 0; j < 4; ++j) { const float a = fmaxf(v0[j], 0.f), b = fmaxf(v1[j], 0.f); v0[j] = a * a; v1[j] = b * b; } }
                    u32x4 w; w.x = cvt_pk_bf16(v0[0], v0[1]); w.y = cvt_pk_bf16(v0[2], v0[3]); w.z = cvt_pk_bf16(v1[0], v1[1]); w.w = cvt_pk_bf16(v1[2], v1[3]);
                    *(u32x4*)(rowp + bj * HALF) = w; } }
    }
};
struct EpiQKV {
    static constexpr bool PERM = true, AFTER_DRAIN = false;
    bf16_t* Qb; bf16_t* Kb; bf16_t* Vt; float qscale;
    DI void operator()(const f32x4 (&acc)[2][2][4][2], const Unit& u, int wr, int wc, int fr, int fq) const {
        const int row0 = u.pm * BM + wr * 64 + fr;
        if (u.pn < 10) {
            const bool isq = u.pn < 8; const float sc = isq ? qscale : 1.0f; const int ldc = isq ? 2048 : 512;
            bf16_t* base = isq ? Qb : Kb; const int col0 = (isq ? u.pn : u.pn - 8) * BM + wc * 32 + 8 * fq;
#pragma unroll
            for (int ai = 0; ai < 2; ++ai)
#pragma unroll
                for (int m = 0; m < 4; ++m) { bf16_t* rowp = base + (size_t)(row0 + ai * HALF + m * 16) * ldc + col0;
#pragma unroll
                    for (int bj = 0; bj < 2; ++bj) { const f32x4 v0 = acc[ai][bj][m][0] * sc, v1 = acc[ai][bj][m][1] * sc;
                        u32x4 w; w.x = cvt_pk_bf16(v0[0], v0[1]); w.y = cvt_pk_bf16(v0[2], v0[3]); w.z = cvt_pk_bf16(v1[0], v1[1]); w.w = cvt_pk_bf16(v1[2], v1[3]);
                        *(u32x4*)(rowp + bj * HALF) = w; } }
        } else {
            const int col0 = (u.pn - 10) * BM + wc * 32 + 8 * fq;
#pragma unroll
            for (int ai = 0; ai < 2; ++ai)
#pragma unroll
                for (int m = 0; m < 4; ++m) { const int row = row0 + ai * HALF + m * 16; const int b = row >> 11, s = row & 2047;
#pragma unroll
                    for (int bj = 0; bj < 2; ++bj)
#pragma unroll
                        for (int n = 0; n < 2; ++n)
#pragma unroll
                            for (int j = 0; j < 4; ++j) { const int c = col0 + bj * HALF + 4 * n + j; Vt[((size_t)b * 512 + c) * S_ + s] = f2bf(acc[ai][bj][m][n][j]); } }
        }
    }
};

DI void conv_t(const float* __restrict__ src, int ldsrc, int col0, int K, int N, const float* __restrict__ gain, bf16_t* __restrict__ dst, bool glu) {
    const size_t total = (size_t)N * (K / 8), stride = (size_t)gridDim.x * 512;
    for (size_t idx = (size_t)lnd_bid() * 512 + lnd_tid(); idx < total; idx += stride) {
        const int n_lo = (int)(idx & 15), kq = (int)((idx >> 4) & 3); const size_t rest = idx >> 6; const int nb16 = N >> 4;
        const int n = (int)(rest % (size_t)nb16) * 16 + n_lo, k0 = ((int)(rest / (size_t)nb16) * 4 + kq) * 8;
        int sc = n; if (glu) { const int pn = n >> 8, bj = (n >> 7) & 1, jj = n & 127; sc = bj * 2048 + pn * 128 + jj; }
        const float* s = src + (size_t)k0 * ldsrc + col0 + sc;
        float v[8];
#pragma unroll
        for (int j = 0; j < 8; ++j) v[j] = s[(size_t)j * ldsrc];
        if (gain) {
#pragma unroll
            for (int j = 0; j < 8; ++j) v[j] *= gain[k0 + j]; }
        u32x4 w; w.x = cvt_pk_bf16(v[0], v[1]); w.y = cvt_pk_bf16(v[2], v[3]); w.z = cvt_pk_bf16(v[4], v[5]); w.w = cvt_pk_bf16(v[6], v[7]);
        *(u32x4*)(dst + (size_t)n * K + k0) = w;
    }
}

template <int MODE> DI void row_phase(const float* __restrict__ x, float* __restrict__ h, const bf16_t* __restrict__ t32, const float* __restrict__ gain, bf16_t* __restrict__ xn) {
    const int tid = lnd_tid(); const int wid = tid >> 6, lane = tid & 63;
    for (int row = lnd_bid() * 8 + wid; row < MT; row += gridDim.x * 8) {
        const size_t ro = (size_t)row * D_;
        f32x4 hv[8];
        if (MODE == 0) {
#pragma unroll
            for (int it = 0; it < 8; ++it) hv[it] = *(const f32x4*)(x + ro + it * 256 + lane * 4);
        } else {
#pragma unroll
            for (int it = 0; it < 8; ++it) hv[it] = __builtin_nontemporal_load((const f32x4*)(h + ro + it * 256 + lane * 4));
        }
        if (MODE == 1 || MODE == 2) {
            f32x4 tv[8]; float ss = 0.f;
#pragma unroll
            for (int it = 0; it < 8; ++it) { { const u32x2 tq = __builtin_nontemporal_load((const u32x2*)(t32 + ro + it * 256 + lane * 4)); tv[it] = (f32x4){__uint_as_float(tq.x << 16), __uint_as_float(tq.x & 0xffff0000u), __uint_as_float(tq.y << 16), __uint_as_float(tq.y & 0xffff0000u)}; } ss += tv[it][0] * tv[it][0] + tv[it][1] * tv[it][1] + tv[it][2] * tv[it][2] + tv[it][3] * tv[it][3]; }
            ss = wave_sum(ss, lane); const float r1 = rsqrtf(ss * (1.0f / D_) + 1e-6f);
#pragma unroll
            for (int it = 0; it < 8; ++it) { const f32x4 g = *(const f32x4*)(gain + it * 256 + lane * 4);
#pragma unroll
                for (int j = 0; j < 4; ++j) hv[it][j] += tv[it][j] * r1 * g[j]; }
        }
        if (MODE != 3) {
#pragma unroll
            for (int it = 0; it < 8; ++it) __builtin_nontemporal_store(hv[it], (f32x4*)(h + ro + it * 256 + lane * 4));
        }
        float r2 = 1.0f;
        if (MODE != 2) { float ss = 0.f;
#pragma unroll
            for (int it = 0; it < 8; ++it) ss += hv[it][0] * hv[it][0] + hv[it][1] * hv[it][1] + hv[it][2] * hv[it][2] + hv[it][3] * hv[it][3];
            ss = wave_sum(ss, lane); r2 = rsqrtf(ss * (1.0f / D_) + 1e-6f); }
#pragma unroll
        for (int it = 0; it < 8; ++it) { u32x2 w; w.x = cvt_pk_bf16(hv[it][0] * r2, hv[it][1] * r2); w.y = cvt_pk_bf16(hv[it][2] * r2, hv[it][3] * r2);
            *(u32x2*)(xn + ro + it * 256 + lane * 4) = w; }
    }
}
DI void conv_p(const float* __restrict__ src, bf16_t* __restrict__ dst) {
    const size_t total = (size_t)MT * PLE / 4, stride = (size_t)gridDim.x * 512;
    for (size_t i = (size_t)lnd_bid() * 512 + lnd_tid(); i < total; i += stride) { const f32x4 v = *(const f32x4*)(src + i * 4); u32x2 w; w.x = cvt_pk_bf16(v[0], v[1]); w.y = cvt_pk_bf16(v[2], v[3]); *(u32x2*)(dst + i * 4) = w; }
}

DI void sincos_pi(float r, float& s, float& c) {
    const float y = r * 0.25f, y2 = y * y;
    float sp = y * (1.0f + y2 * (-1.6666667e-1f + y2 * (8.3333333e-3f + y2 * (-1.9841270e-4f + y2 * 2.7557319e-6f))));
    float cp = 1.0f + y2 * (-0.5f + y2 * (4.1666667e-2f + y2 * (-1.3888889e-3f + y2 * (2.4801587e-5f + y2 * -2.7557319e-7f))));
    const float s2 = 2.f * sp * cp, c2 = 1.f - 2.f * sp * sp;
    s = 2.f * s2 * c2; c = 1.f - 2.f * s2 * s2;
}
typedef short s16x4 __attribute__((ext_vector_type(4)));
DI void scan_phase(PG8_LAS unsigned char* lds, const float* a_re_, const float* a_im_, const float* log_step_, const float* b_re_, const float* b_im_, const float* c_re_, const float* c_im_, const float* d_, int j, const bf16_t* __restrict__ U, bf16_t* __restrict__ Y) {
    const int tid = lnd_tid(); const int wid = tid >> 6, lane = tid & 63, l15 = lane & 15, lq = lane >> 4;
    PG8_LAS unsigned char* xl = lds + wid * (16 * 272);
    for (int item = lnd_bid() * 8 + wid; item < B_ * NG; item += gridDim.x * 8) {
        const int b = item / NG, g = item % NG;
        const float dt = expf(log_step_[j * NG + g]);
        float l1r[4], l1i[4], l2r[4], l2i[4], l3r[4], l3i[4], l4r[4], l4i[4];
        s16x4 bfr[8];
#pragma unroll
        for (int a = 0; a < 4; ++a) {
            const int p = 16 * a + l15;
            const float ar = a_re_[((size_t)j * NG + g) * NP + p], ai = a_im_[((size_t)j * NG + g) * NP + p];
            const float mag = expf(ar * dt);
            const float ang = ai * dt;
            const float kk = rintf(ang * 0.15915494309189535f);
            float rr = fmaf(-kk, 6.28125f, ang); rr = fmaf(-kk, 0.0019353071795864769f, rr);
            float sn, cs; sincos_pi(rr, sn, cs);
            const float lbr = mag * cs, lbi = mag * sn;
            const float den = ar * ar + ai * ai, nr = lbr - 1.0f;
            const float fr = (nr * ar + lbi * ai) / den, fi = (lbi * ar - nr * ai) / den;
            float vr[4], vi[4];
#pragma unroll
            for (int jj = 0; jj < 4; ++jj) { const size_t bi_ = (((size_t)j * NG + g) * NP + p) * 16 + 4 * lq + jj; const float br = b_re_[bi_], bi = b_im_[bi_];
                vr[jj] = fr * br - fi * bi; vi[jj] = fr * bi + fi * br; }
            u32x2 wr_, wi_; wr_.x = cvt_pk_bf16(vr[0], vr[1]); wr_.y = cvt_pk_bf16(vr[2], vr[3]); wi_.x = cvt_pk_bf16(vi[0], vi[1]); wi_.y = cvt_pk_bf16(vi[2], vi[3]);
            bfr[a] = __builtin_bit_cast(s16x4, wr_); bfr[4 + a] = __builtin_bit_cast(s16x4, wi_);
            l1r[a] = lbr; l1i[a] = lbi;
            l2r[a] = lbr * lbr - lbi * lbi; l2i[a] = 2.f * lbr * lbi;
            l3r[a] = l2r[a] * lbr - l2i[a] * lbi; l3i[a] = l2r[a] * lbi + l2i[a] * lbr;
            l4r[a] = l2r[a] * l2r[a] - l2i[a] * l2i[a]; l4i[a] = 2.f * l2r[a] * l2i[a];
        }
        bf16x8 cm[4];
#pragma unroll
        for (int ks = 0; ks < 4; ++ks) { u32x4 w;
#pragma unroll
            for (int pr = 0; pr < 4; ++pr) { const int pp = 16 * ks + 4 * lq + pr; const size_t ci = (((size_t)j * NG + g) * 16 + l15) * NP + pp;
                w[pr] = cvt_pk_bf16(c_re_[ci], -c_im_[ci]); }
            cm[ks] = __builtin_bit_cast(bf16x8, w); }
        const float dsk = d_[j * D_ + g * 16 + l15];
        const size_t base = (size_t)b * S_ * D_ + g * 16 + l15 + (size_t)(4 * lq) * D_;
        const size_t abase = (size_t)b * S_ * D_ + (size_t)l15 * D_ + g * 16 + 4 * lq;
        float cr[4] = {0.f, 0.f, 0.f, 0.f}, ci[4] = {0.f, 0.f, 0.f, 0.f};
        float un[4]; u32x2 an;
#pragma unroll
        for (int q = 0; q < 4; ++q) un[q] = bf2f(U[base + (size_t)q * D_]);
        an = *(const u32x2*)(U + abase);
        for (int t0 = 0; t0 < S_; t0 += 16) {
            float uv[4]; const s16x4 au = __builtin_bit_cast(s16x4, an);
#pragma unroll
            for (int q = 0; q < 4; ++q) uv[q] = un[q];
            if (t0 + 16 < S_) {
#pragma unroll
                for (int q = 0; q < 4; ++q) un[q] = bf2f(U[base + (size_t)(t0 + 16 + q) * D_]);
                an = *(const u32x2*)(U + abase + (size_t)(t0 + 16) * D_); }
#pragma unroll
            for (int a = 0; a < 4; ++a) {
                const f32x4 z4 = (f32x4){0.f, 0.f, 0.f, 0.f};
                const f32x4 bur = __builtin_amdgcn_mfma_f32_16x16x16bf16_1k(au, bfr[a], z4, 0, 0, 0), bui = __builtin_amdgcn_mfma_f32_16x16x16bf16_1k(au, bfr[4 + a], z4, 0, 0, 0);
                float xr[4], xi[4];
                xr[0] = bur[0]; xi[0] = bui[0];
#pragma unroll
                for (int i = 1; i < 4; ++i) { xr[i] = l1r[a] * xr[i - 1] - l1i[a] * xi[i - 1] + bur[i]; xi[i] = l1r[a] * xi[i - 1] + l1i[a] * xr[i - 1] + bui[i]; }
                float c_r = cr[a], c_i = ci[a], mr = c_r, mi = c_i;
#pragma unroll
                for (int q = 0; q < 4; ++q) {
                    const float er = __builtin_bit_cast(float, __builtin_amdgcn_ds_bpermute((16 * q + l15) << 2, __builtin_bit_cast(int, xr[3])));
                    const float ei = __builtin_bit_cast(float, __builtin_amdgcn_ds_bpermute((16 * q + l15) << 2, __builtin_bit_cast(int, xi[3])));
                    if (lq == q) { mr = c_r; mi = c_i; }
                    const float nr_ = l4r[a] * c_r - l4i[a] * c_i + er, ni_ = l4r[a] * c_i + l4i[a] * c_r + ei;
                    c_r = nr_; c_i = ni_;
                }
                cr[a] = c_r; ci[a] = c_i;
                const float pr_[4] = {l1r[a], l2r[a], l3r[a], l4r[a]}, pi_[4] = {l1i[a], l2i[a], l3i[a], l4i[a]};
#pragma unroll
                for (int i = 0; i < 4; ++i) {
                    const float fxr = xr[i] + pr_[i] * mr - pi_[i] * mi, fxi = xi[i] + pr_[i] * mi + pi_[i] * mr;
                    *(PG8_LAS unsigned*)(xl + (4 * lq + i) * 272 + (16 * a + l15) * 4) = cvt_pk_bf16(fxr, fxi);
                }
            }
            f32x4 acc = (f32x4){0.f, 0.f, 0.f, 0.f};
#pragma unroll
            for (int ks = 0; ks < 4; ++ks) { const bf16x8 af = *(const PG8_LAS bf16x8*)(xl + l15 * 272 + ks * 64 + lq * 16); acc = __builtin_amdgcn_mfma_f32_16x16x32_bf16(af, cm[ks], acc, 0, 0, 0); }
#pragma unroll
            for (int i = 0; i < 4; ++i) {
                const float yv = acc[i] + dsk * uv[i];
                const float a2 = 1.5957691216057308f * (yv + 0.044715f * yv * yv * yv);
                const float gl = yv * __builtin_amdgcn_rcpf(1.0f + __expf(-a2));
                Y[base + (size_t)(t0 + i) * D_] = f2bf(gl);
            }
        }
    }
}

constexpr int KROW = 272, VROW = 80, KBUF = 32 * KROW, VBUF = 128 * VROW;
DI void attn_phase(PG8_LAS unsigned char* lds, const bf16_t* __restrict__ Q, const bf16_t* __restrict__ Kb, const bf16_t* __restrict__ Vt, bf16_t* __restrict__ O) {
    const int tid = lnd_tid(), bid = lnd_bid(), wid = tid >> 6, lane = tid & 63, r = lane & 31, hh = lane >> 5, hql = wid & 3, wh = wid >> 2;
    PG8_LAS unsigned char* kbuf = lds; PG8_LAS unsigned char* vbuf = lds + 2 * KBUF;
    for (int pi = 0; pi < 4; ++pi) {
        const int PP = bid * 4 + pi; if (PP >= B_ * 4 * 16) break;
        const int pq = PP & 15, hk = (PP >> 4) & 3, b = PP >> 6;
        for (int hf = 0; hf < 2; ++hf) {
            const int qb = hf ? 31 - pq : pq, q0 = qb * 64;
            const int t = q0 + 32 * wh + r; const size_t token = (size_t)b * S_ + t; const int hq = hk * 4 + hql;
            bf16x8 qf[8];
#pragma unroll
            for (int st = 0; st < 8; ++st) qf[st] = *(const bf16x8*)(Q + token * D_ + hq * 128 + st * 16 + hh * 8);
            f32x16 oacc[4];
#pragma unroll
            for (int mt = 0; mt < 4; ++mt)
#pragma unroll
                for (int i = 0; i < 16; ++i) oacc[mt][i] = 0.f;
            float carry = 1.0f;
            const int ntiles = 2 * qb + 2, mydiag = 2 * qb + wh;
            const bf16_t* gK = Kb + ((size_t)b * S_ + (tid >> 4)) * 512 + hk * 128 + (tid & 15) * 8;
            const bf16_t* gV = Vt + ((size_t)(b * 4 + hk) * 128 + (tid >> 2)) * S_ + (tid & 3) * 8;
            const int kw = (tid >> 4) * KROW + (tid & 15) * 16, vw = (tid >> 2) * VROW + (tid & 3) * 8;
            u32x4 rk = *(const u32x4*)(gK + (size_t)(ntiles - 1) * 32 * 512), rv = *(const u32x4*)(gV + (ntiles - 1) * 32);
            *(PG8_LAS u32x4*)(kbuf + kw) = rk;
            *(PG8_LAS u32x2*)(vbuf + vw) = (u32x2){rv.x, rv.y}; *(PG8_LAS u32x2*)(vbuf + vw + 32) = (u32x2){rv.z, rv.w};
            __syncthreads();
            for (int it = 0; it < ntiles; ++it) {
                const int kt = ntiles - 1 - it, cur = it & 1; const bool more = it + 1 < ntiles;
                if (more) { rk = *(const u32x4*)(gK + (size_t)(kt - 1) * 32 * 512); rv = *(const u32x4*)(gV + (kt - 1) * 32); }
                if (kt <= mydiag) {
                    f32x16 sacc;
#pragma unroll
                    for (int i = 0; i < 16; ++i) sacc[i] = 0.f;
                    PG8_LAS unsigned char* kp = kbuf + cur * KBUF + r * KROW + hh * 16;
#pragma unroll
                    for (int st = 0; st < 8; ++st) { const bf16x8 kf = *(const PG8_LAS bf16x8*)(kp + st * 32); sacc = __builtin_amdgcn_mfma_f32_32x32x16_bf16(kf, qf[st], sacc, 0, 0, 0); }
                    const bool diag = (kt == mydiag);
                    float kq[16], w[16];
#pragma unroll
                    for (int i = 0; i < 16; ++i) {
                        const int cw = (i & 3) + 8 * (i >> 2) + 4 * hh; const bool valid = !diag || (cw < r);
                        const float E = __builtin_amdgcn_exp2f(fminf(sacc[i], 80.f)); const float rkp = __builtin_amdgcn_rcpf(1.0f + E);
                        kq[i] = valid ? rkp : 1.0f; w[i] = valid ? E * rkp : 0.f;
                    }
                    float gs[4], pg[4];
#pragma unroll
                    for (int g = 0; g < 4; ++g) { gs[g] = (kq[4 * g] * kq[4 * g + 1]) * (kq[4 * g + 2] * kq[4 * g + 3]); pg[g] = shx(gs[g], lane, 32); }
                    float T[4]; T[3] = 1.0f; T[2] = gs[3] * pg[3]; T[1] = T[2] * (gs[2] * pg[2]); T[0] = T[1] * (gs[1] * pg[1]);
                    const float total = T[0] * (gs[0] * pg[0]);
#pragma unroll
                    for (int g = 0; g < 4; ++g) { float run = carry * T[g] * (hh == 0 ? pg[g] : 1.0f);
#pragma unroll
                        for (int jj = 3; jj >= 0; --jj) { const int i = 4 * g + jj; w[i] *= run; run *= kq[i]; } }
                    carry *= total;
                    u32x4 p0, p1;
                    p0.x = cvt_pk_bf16(w[0], w[1]); p0.y = cvt_pk_bf16(w[2], w[3]); p0.z = cvt_pk_bf16(w[4], w[5]); p0.w = cvt_pk_bf16(w[6], w[7]);
                    p1.x = cvt_pk_bf16(w[8], w[9]); p1.y = cvt_pk_bf16(w[10], w[11]); p1.z = cvt_pk_bf16(w[12], w[13]); p1.w = cvt_pk_bf16(w[14], w[15]);
                    const bf16x8 pb0 = __builtin_bit_cast(bf16x8, p0), pb1 = __builtin_bit_cast(bf16x8, p1);
                    PG8_LAS unsigned char* vp = vbuf + cur * VBUF + r * VROW + hh * 32;
#pragma unroll
                    for (int mt = 0; mt < 4; ++mt) {
                        const bf16x8 va = *(const PG8_LAS bf16x8*)(vp + mt * 32 * VROW), vb = *(const PG8_LAS bf16x8*)(vp + mt * 32 * VROW + 16);
                        oacc[mt] = __builtin_amdgcn_mfma_f32_32x32x16_bf16(va, pb0, oacc[mt], 0, 0, 0);
                        oacc[mt] = __builtin_amdgcn_mfma_f32_32x32x16_bf16(vb, pb1, oacc[mt], 0, 0, 0);
                    }
                }
                if (more) {
                    *(PG8_LAS u32x4*)(kbuf + (cur ^ 1) * KBUF + kw) = rk;
                    *(PG8_LAS u32x2*)(vbuf + (cur ^ 1) * VBUF + vw) = (u32x2){rv.x, rv.y}; *(PG8_LAS u32x2*)(vbuf + (cur ^ 1) * VBUF + vw + 32) = (u32x2){rv.z, rv.w};
                }
                __syncthreads();
            }
            bf16_t* op = O + token * D_ + hq * 128 + 4 * hh;
#pragma unroll
            for (int mt = 0; mt < 4; ++mt)
#pragma unroll
                for (int g = 0; g < 4; ++g) { u32x2 w2; w2.x = cvt_pk_bf16(oacc[mt][4 * g], oacc[mt][4 * g + 1]); w2.y = cvt_pk_bf16(oacc[mt][4 * g + 2], oacc[mt][4 * g + 3]);
                    *(u32x2*)(op + mt * 32 + g * 8) = w2; }
        }
    }
}

#define GRID_SYNC() do { XcdBarrier b2_ = bar; asm volatile("" : "+s"(b2_.bar)); xcd_barrier(b2_); } while (0)
#ifndef NO_GEMM
#define GEMMCALL gemm_phase(lds, g, S, E, nullptr);
#else
#define GEMMCALL E(*(const f32x4 (*)[2][2][4][2])nullptr, Unit{0,0},0,0,0,0);
#endif
__global__ void __launch_bounds__(512, 2) mega(Params P_unused) {
#define P (*(const __attribute__((address_space(4))) Params*)__builtin_amdgcn_kernarg_segment_ptr())
    extern __shared__ __attribute__((aligned(16))) unsigned char shm[];
    PG8_LAS unsigned char* lds = (PG8_LAS unsigned char*)shm;
    volatile LAS unsigned* xbw = (volatile LAS unsigned*)(lds + LDS_GEMM);
    if (threadIdx.x == 0) { xbw[0] = 0u; xbw[1] = 0u; xbw[2] = 0u; xbw[3] = 0u; }
    __syncthreads();
    XcdBarrier bar = xcd_barrier_post(P.bar, xbw);
    const int G = gridDim.x, c = blockIdx.x;
    const float qscale = 0.08838834764831845f * 1.4426950408889634f;

#ifdef PROBE_PRO
#pragma unroll 1
    for (int rep_ = 0; rep_ < 2; ++rep_)
#endif
#pragma unroll 1
    for (int w = 0; w < 26; ++w) {
        const float* src; const float* gain = nullptr; bf16_t* dst; int ldsrc = D_, K = D_, N = D_; bool glu = false;
        if (w < 2)       { src = P.ssm_w_in + (size_t)w * D_ * D_; gain = P.a_norm_pre + w * D_; dst = P.wb + W_IN0 + (size_t)w * D_ * D_; }
        else if (w < 4)  { const int j = w - 2; src = P.ssm_w_glu + (size_t)j * D_ * 2 * D_; ldsrc = 2 * D_; N = 2 * D_; dst = P.wb + W_GLU0 + (size_t)j * 2 * D_ * D_; glu = true; }
        else if (w < 6)  { const int j = w - 4; src = P.w_o + (size_t)j * D_ * D_; dst = P.wb + W_O0 + (size_t)j * D_ * D_; }
        else if (w == 6) { src = P.w_q; gain = P.b_norm_pre; dst = P.wb + W_QKV0; }
        else if (w == 7) { src = P.w_k; ldsrc = 512; N = 512; gain = P.kv_norm; dst = P.wb + W_QKV0 + 2048ull * D_; }
        else if (w == 8) { src = P.w_v; ldsrc = 512; N = 512; gain = P.kv_norm; dst = P.wb + W_QKV0 + 2560ull * D_; }
        else if (w == 9) { src = P.w_q + (size_t)D_ * D_; gain = P.b_norm_pre + D_; dst = P.wb + W_Q1; }
        else if (w < 14) { const int i = w - 10; src = P.mlp_w1 + (size_t)i * D_ * DFF; ldsrc = DFF; N = DFF; gain = P.mlp_norm_pre + i * D_; dst = P.wb + W_10 + (size_t)i * DFF * D_; }
        else if (w < 18) { const int i = w - 14; src = P.mlp_w2 + (size_t)i * DFF * D_; K = DFF; dst = P.wb + W_20 + (size_t)i * DFF * D_; }
        else if (w < 22) { const int i = w - 18; src = P.ple_w + (size_t)i * PLE * D_; K = PLE; dst = P.wb + W_PLE0 + (size_t)i * D_ * PLE; }
        else             { const int i = w - 22; src = P.ple_gate + (size_t)i * D_ * D_; dst = P.wb + W_GATE0 + (size_t)i * D_ * D_; }
        conv_t(src, ldsrc, 0, K, N, gain, dst, glu);
    }
    row_phase<0>(P.x, P.h, nullptr, nullptr, P.xn);
    GRID_SYNC();

#pragma unroll 1
    for (int layer = 0; layer < 4; ++layer) {
        if (layer < 2) {
            const int j = layer;
            { Gemm g{P.xn, P.wb + W_IN0 + (size_t)j * D_ * D_, MT, D_, D_}; StaticOrder S; S.init(g.M, g.N, G, lnd_bid()); EpiB16<0> E{P.big, D_}; GEMMCALL }
            GRID_SYNC();
#ifndef NO_SCAN
            scan_phase(lds, P.ssm_a_re, P.ssm_a_im, P.ssm_log_step, P.ssm_b_re, P.ssm_b_im, P.ssm_c_re, P.ssm_c_im, P.ssm_d, j, P.big, P.xn);
#endif
            GRID_SYNC();
            { Gemm g{P.xn, P.wb + W_GLU0 + (size_t)j * 2 * D_ * D_, MT, 2 * D_, D_}; StaticOrder S; S.init(g.M, g.N, G, lnd_bid()); EpiGlu E{P.t32}; GEMMCALL }
            GRID_SYNC();
            row_phase<1>(nullptr, P.h, P.t32, P.a_norm_post + j * D_, P.xn);
            GRID_SYNC();
        } else {
            const int j = layer - 2;
            if (j == 0) { Gemm g{P.xn, P.wb + W_QKV0, MT, 3072, D_}; StaticOrder S; S.init(g.M, g.N, G, lnd_bid()); EpiQKV E{P.big, P.kb, P.vt, qscale}; GEMMCALL }
            else        { Gemm g{P.xn, P.wb + W_Q1, MT, D_, D_}; StaticOrder S; S.init(g.M, g.N, G, lnd_bid()); EpiQKV E{P.big, P.kb, P.vt, qscale}; GEMMCALL }
            GRID_SYNC();
#ifndef NO_ATTN
            attn_phase(lds, P.big, P.kb, P.vt, P.xn);
#endif
            GRID_SYNC();
            { Gemm g{P.xn, P.wb + W_O0 + (size_t)j * D_ * D_, MT, D_, D_}; StaticOrder S; S.init(g.M, g.N, G, lnd_bid()); EpiB16<0> E{P.t32, D_}; GEMMCALL }
            GRID_SYNC();
            row_phase<1>(nullptr, P.h, P.t32, P.b_norm_post + j * D_, P.xn);
            GRID_SYNC();
        }
#pragma unroll 1
        for (int ch = 0; ch < MT / MCH; ++ch) {
            { Gemm g{P.xn + (size_t)ch * MCH * D_, P.wb + W_10 + (size_t)layer * DFF * D_, MCH, DFF, D_}; StaticOrder S; S.init(g.M, g.N, G, lnd_bid()); EpiB16<1> E{P.big, DFF}; GEMMCALL }
            GRID_SYNC();
            { Gemm g{P.big, P.wb + W_20 + (size_t)layer * DFF * D_, MCH, D_, DFF}; StaticOrder S; S.init(g.M, g.N, G, lnd_bid()); EpiB16<0> E{P.t32 + (size_t)ch * MCH * D_, D_}; GEMMCALL }
            GRID_SYNC();
        }
        row_phase<2>(nullptr, P.h, P.t32, P.mlp_norm_post + layer * D_, P.xn);
        conv_p(P.p + (size_t)layer * MT * PLE, P.pb);
        GRID_SYNC();
        { Gemm g{P.xn, P.wb + W_GATE0 + (size_t)layer * D_ * D_, MT, D_, D_}; StaticOrder S; S.init(g.M, g.N, G, lnd_bid()); EpiB16<0> E{P.t32, D_}; GEMMCALL }
        GRID_SYNC();
        { Gemm g{P.pb, P.wb + W_PLE0 + (size_t)layer * D_ * PLE, MT, D_, PLE}; StaticOrder S; S.init(g.M, g.N, G, lnd_bid()); EpiPle E{P.h, P.t32}; GEMMCALL }
        GRID_SYNC();
        if (layer < 3) { row_phase<3>(nullptr, P.h, nullptr, nullptr, P.xn); GRID_SYNC(); }
#ifdef PROBE_ROW3
        if (layer < 3) { row_phase<3>(nullptr, P.h, nullptr, nullptr, P.xn); GRID_SYNC(); }
#endif
    }
}
#undef P

extern "C" void kernel_launch(void* const* d_in, const int* in_sizes, int n_in, void* d_out, int out_size, void* d_ws, size_t ws_size, hipStream_t stream) {
    (void)in_sizes; (void)n_in; (void)out_size;
    if (ws_size < WS_NEED) { fprintf(stderr, "workspace too small: %zu < %zu\n", ws_size, (size_t)WS_NEED); return; }
    static bool attr_set = false;
    if (!attr_set) { hipFuncSetAttribute((const void*)mega, hipFuncAttributeMaxDynamicSharedMemorySize, LDS_TOTAL); attr_set = true; }
    unsigned char* ws = (unsigned char*)d_ws;
    Params P{};
    const float** f = (const float**)&P;
    for (int i = 0; i < 27; ++i) f[i] = (const float*)d_in[i];
    P.h = (float*)d_out; P.bar = (unsigned*)(ws + OFF_BAR); P.wb = (bf16_t*)(ws + OFF_WB); P.xn = (bf16_t*)(ws + OFF_XN); P.big = (bf16_t*)(ws + OFF_BIG);
    P.t32 = (bf16_t*)(ws + OFF_T32); P.kb = (bf16_t*)(ws + OFF_KB); P.vt = (bf16_t*)(ws + OFF_VT); P.pb = (bf16_t*)(ws + OFF_PB);
    hipMemsetAsync(P.bar, 0, XCD_BAR_WORDS * sizeof(unsigned), stream);
    int dev = 0, cus = 256; hipGetDevice(&dev); hipDeviceGetAttribute(&cus, hipDeviceAttributeMultiprocessorCount, dev);
    hipLaunchKernelGGL(mega, dim3(cus), dim3(512), LDS_TOTAL, stream, P);
}
```
